# Optimizing an MI355X kernel written in HIP

```python
import math
import jax, jax.numpy as jnp
from jax import lax
import numpy as np

D_MODEL = 1024
BATCH = 8
SEQ = 4096
DEPTH = 1

ATTN_HEADS = 8
ATTN_KV_HEADS = 2
ATTN_HEAD_DIM = 64
ATTN_GROUP = ATTN_HEADS // ATTN_KV_HEADS
WINDOW = 128
ATTN_BLOCK = WINDOW
ATTN_Q_WIDTH = ATTN_HEADS * ATTN_HEAD_DIM
ATTN_KV_WIDTH = ATTN_KV_HEADS * ATTN_HEAD_DIM
MLSTM_HEADS = 4
MLSTM_QK_DIM = 64
MLSTM_V_DIM = 128
MLSTM_QK_WIDTH = MLSTM_HEADS * MLSTM_QK_DIM
MLSTM_V_WIDTH = MLSTM_HEADS * MLSTM_V_DIM
MLSTM_CHUNK = 128
CONV_WIDTH = 4
D_FF = -(-(8 * D_MODEL) // (3 * 256)) * 256
NORM_EPS = 1e-6

SPLIT_SIZES = (ATTN_Q_WIDTH, ATTN_KV_WIDTH, ATTN_KV_WIDTH,
               2 * MLSTM_QK_WIDTH, MLSTM_V_WIDTH,
               MLSTM_V_WIDTH, MLSTM_HEADS, MLSTM_HEADS,
               D_MODEL, D_MODEL)
IN_WIDTH = sum(SPLIT_SIZES)

kernel_name = "hybrid_swa_sink_alibi_mlstm_gated_swiglu"


def _split_points():
    pts, acc = [], 0
    for s in SPLIT_SIZES[:-1]:
        acc += s
        pts.append(acc)
    return pts


def rmsnorm(x, g):
    x32 = x.astype(jnp.float32)
    y = x32 * lax.rsqrt(jnp.mean(x32 * x32, axis=-1, keepdims=True) + NORM_EPS)
    return (y * g.astype(jnp.float32)).astype(x.dtype)


def alibi_slopes(n_heads):
    return jnp.exp2(-8.0 * jnp.arange(1, n_heads + 1, dtype=jnp.float32) / n_heads)


def sliding_window_attention(q, k, v, sinks):
    B, S, _ = q.shape
    W = ATTN_BLOCK
    nb = S // W
    qb = q.reshape(B, nb, W, ATTN_KV_HEADS, ATTN_GROUP, ATTN_HEAD_DIM)
    kb = k.reshape(B, nb, W, ATTN_KV_HEADS, ATTN_HEAD_DIM)
    vb = v.reshape(B, nb, W, ATTN_KV_HEADS, ATTN_HEAD_DIM)

    def with_prev(t):
        prev = jnp.pad(t, ((0, 0), (1, 0), (0, 0), (0, 0), (0, 0)))[:, :-1]
        return jnp.concatenate([prev, t], axis=2)

    kk, vv = with_prev(kb), with_prev(vb)
    s = jnp.einsum('bnqhgd,bnkhd->bhgnqk', qb, kk, preferred_element_type=jnp.float32)
    s = s * (ATTN_HEAD_DIM ** -0.5)
    qi = jnp.arange(W)[:, None]
    kj = jnp.arange(2 * W)[None, :]
    dist = qi - kj + W
    blk = jnp.arange(nb)[:, None, None]
    valid = (dist >= 0) & (dist < WINDOW) & ((blk > 0) | (kj >= W))
    slopes = alibi_slopes(ATTN_HEADS).reshape(ATTN_KV_HEADS, ATTN_GROUP)
    s = s - slopes[:, :, None, None, None] * dist.astype(jnp.float32)
    s = jnp.where(valid, s, -jnp.inf)
    sink = sinks.astype(jnp.float32).reshape(ATTN_KV_HEADS, ATTN_GROUP)[:, :, None, None, None]
    mx = jnp.maximum(jnp.max(s, axis=-1, keepdims=True), sink)
    p = jnp.exp(s - mx)
    p = p / (jnp.sum(p, axis=-1, keepdims=True) + jnp.exp(sink - mx))
    o = jnp.einsum('bhgnqk,bnkhd->bnqhgd', p.astype(v.dtype), vv)
    return o.reshape(B, S, ATTN_Q_WIDTH)


def causal_conv(x, w, b):
    S = x.shape[1]
    xp = jnp.pad(x, ((0, 0), (CONV_WIDTH - 1, 0), (0, 0)))
    out = xp[:, 0:S] * w[0]
    for j in range(1, CONV_WIDTH):
        out = out + xp[:, j:j + S] * w[j]
    return out + b


def mlstm_chunkwise(q, k, v, i_pre, f_pre):
    B, S, H, dk = q.shape
    dv = v.shape[-1]
    L = MLSTM_CHUNK
    nc = S // L

    def chunks(t):
        return t.astype(jnp.float32).reshape(B, nc, L, H, -1).transpose(1, 0, 3, 2, 4)

    def gchunks(t):
        return t.astype(jnp.float32).reshape(B, nc, L, H).transpose(1, 0, 3, 2)

    qs = chunks(q)
    ks = chunks(k) * (dk ** -0.5)
    vs = chunks(v)
    igs = gchunks(i_pre)
    lfs = gchunks(jax.nn.log_sigmoid(f_pre.astype(jnp.float32)))
    causal = jnp.tril(jnp.ones((L, L), dtype=bool))

    def step(carry, xs):
        C, n, m = carry
        qc, kc, vc, ic, lfc = xs
        b = jnp.cumsum(lfc, axis=-1)
        dlog = b[..., :, None] - b[..., None, :] + ic[..., None, :]
        dlog = jnp.where(causal, dlog, -jnp.inf)
        a = b + m[..., None]
        m_t = jnp.maximum(a, jnp.max(dlog, axis=-1))
        w_intra = jnp.exp(dlog - m_t[..., None])
        w_inter = jnp.exp(a - m_t)
        sc = jnp.einsum('bhtd,bhsd->bhts', qc, kc) * w_intra
        num = jnp.einsum('bhts,bhsv->bhtv', sc, vc) + w_inter[..., None] * jnp.einsum('bhtk,bhkv->bhtv', qc, C)
        nq = jnp.sum(sc, axis=-1) + w_inter * jnp.einsum('bhtk,bhk->bht', qc, n)
        h = num / jnp.maximum(jnp.abs(nq), jnp.exp(-m_t))[..., None]
        m_new = m_t[..., -1]
        w_state = jnp.exp(b[..., -1:] - b + ic - m_new[..., None])
        decay = jnp.exp(b[..., -1] + m - m_new)
        C_new = decay[..., None, None] * C + jnp.einsum('bhs,bhsk,bhsv->bhkv', w_state, kc, vc)
        n_new = decay[..., None] * n + jnp.einsum('bhs,bhsk->bhk', w_state, kc)
        return (C_new, n_new, m_new), h

    init = (jnp.zeros((B, H, dk, dv), jnp.float32),
            jnp.zeros((B, H, dk), jnp.float32),
            jnp.zeros((B, H), jnp.float32))
    _, hs = lax.scan(step, init, (qs, ks, vs, igs, lfs))
    return hs.transpose(1, 0, 3, 2, 4).reshape(B, S, H, dv)


def hybrid_layer(x, norm1_g, w_in, conv_w, conv_b, i_bias, f_bias, mlstm_norm_g, attn_sinks,
                 w_attn_branch, w_mlstm_branch, w_out, norm2_g, w_ffn_gate, w_ffn_up, w_ffn_down):
    B, S, _ = x.shape
    u = rmsnorm(x, norm1_g)
    proj = u @ w_in
    aq, ak, av, mqk, mv, mo, mi, mf, ga, gm = jnp.split(proj, _split_points(), axis=-1)

    ya = sliding_window_attention(aq, ak, av, attn_sinks) @ w_attn_branch

    qk = jax.nn.silu(causal_conv(mqk, conv_w, conv_b))
    mq, mk = jnp.split(qk, 2, axis=-1)
    h = mlstm_chunkwise(mq.reshape(B, S, MLSTM_HEADS, MLSTM_QK_DIM),
                        mk.reshape(B, S, MLSTM_HEADS, MLSTM_QK_DIM),
                        mv.reshape(B, S, MLSTM_HEADS, MLSTM_V_DIM),
                        mi + i_bias, mf + f_bias)
    h = rmsnorm(h, mlstm_norm_g.reshape(MLSTM_HEADS, MLSTM_V_DIM)).astype(x.dtype)
    h = h.reshape(B, S, MLSTM_V_WIDTH) * jax.nn.sigmoid(mo)
    ym = h @ w_mlstm_branch

    x = x + (jax.nn.sigmoid(ga) * ya + jax.nn.sigmoid(gm) * ym) @ w_out

    f = rmsnorm(x, norm2_g)
    x = x + (jax.nn.silu(f @ w_ffn_gate) * (f @ w_ffn_up)) @ w_ffn_down
    return x


def setup_inputs(seed: int = 0) -> dict:
    key = jax.random.key(seed)
    ks = jax.random.split(key, 20)
    f32 = jnp.float32

    def nrm(k, shape, scale):
        return jax.random.normal(k, shape, f32) * scale

    return {
        "x": nrm(ks[0], (BATCH, SEQ, D_MODEL), 1.0),
        "norm1_g": 1.0 + nrm(ks[1], (DEPTH, D_MODEL), 0.02),
        "w_in": nrm(ks[2], (DEPTH, D_MODEL, IN_WIDTH), D_MODEL ** -0.5),
        "conv_w": nrm(ks[3], (DEPTH, CONV_WIDTH, 2 * MLSTM_QK_WIDTH), CONV_WIDTH ** -0.5),
        "conv_b": nrm(ks[4], (DEPTH, 2 * MLSTM_QK_WIDTH), 0.01),
        "i_bias": nrm(ks[5], (DEPTH, MLSTM_HEADS), 0.1),
        "f_bias": jnp.linspace(3.0, 6.0, MLSTM_HEADS, dtype=f32)[None, :] + nrm(ks[6], (DEPTH, MLSTM_HEADS), 0.1),
        "mlstm_norm_g": 1.0 + nrm(ks[7], (DEPTH, MLSTM_V_WIDTH), 0.02),
        "attn_sinks": nrm(ks[8], (DEPTH, ATTN_HEADS), 0.5),
        "w_attn_branch": nrm(ks[9], (DEPTH, ATTN_Q_WIDTH, D_MODEL), ATTN_Q_WIDTH ** -0.5),
        "w_mlstm_branch": nrm(ks[10], (DEPTH, MLSTM_V_WIDTH, D_MODEL), MLSTM_V_WIDTH ** -0.5),
        "w_out": nrm(ks[11], (DEPTH, D_MODEL, D_MODEL), D_MODEL ** -0.5),
        "norm2_g": 1.0 + nrm(ks[12], (DEPTH, D_MODEL), 0.02),
        "w_ffn_gate": nrm(ks[13], (DEPTH, D_MODEL, D_FF), D_MODEL ** -0.5),
        "w_ffn_up": nrm(ks[14], (DEPTH, D_MODEL, D_FF), D_MODEL ** -0.5),
        "w_ffn_down": nrm(ks[15], (DEPTH, D_FF, D_MODEL), D_FF ** -0.5),
        "final_norm_g": 1.0 + nrm(ks[16], (D_MODEL,), 0.02),
    }


def reference(x, norm1_g, w_in, conv_w, conv_b, i_bias, f_bias, mlstm_norm_g, attn_sinks,
              w_attn_branch, w_mlstm_branch, w_out, norm2_g, w_ffn_gate, w_ffn_up, w_ffn_down,
              final_norm_g):
    for l in range(DEPTH):
        x = hybrid_layer(x, norm1_g[l], w_in[l], conv_w[l], conv_b[l], i_bias[l], f_bias[l],
                         mlstm_norm_g[l], attn_sinks[l], w_attn_branch[l], w_mlstm_branch[l],
                         w_out[l], norm2_g[l], w_ffn_gate[l], w_ffn_up[l], w_ffn_down[l])
    return rmsnorm(x, final_norm_g)
```

```cpp
#include <hip/hip_runtime.h>
#include <cstdio>
#include <cstdint>

namespace cfg {
constexpr int BATCH = 8, SEQ = 4096, D = 1024, M = BATCH * SEQ, INW = 4360, FF = 2816;
constexpr int C_AQ = 0, C_AK = 512, C_AV = 640, C_MQK = 768, C_MV = 1280, C_MO = 1792, C_MI = 2304, C_MF = 2308, C_GA = 2312, C_GM = 3336;
constexpr float EPS = 1e-6f, LOG2E = 1.4426950408889634f, QSCALE = 0.125f * LOG2E;
constexpr size_t MiB = 1u << 20;
constexpr size_t WS_CTL = 0;
constexpr size_t WS_GATES = 1 * MiB;
constexpr size_t WS_SS1 = 2 * MiB;
constexpr size_t WS_MSM = 3 * MiB;
constexpr size_t WS_WIN = 8 * MiB;
constexpr size_t WS_WA = 17 * MiB, WS_WM = 18 * MiB, WS_WO = 19 * MiB, WS_WGU = 21 * MiB, WS_WD = 32 * MiB;
constexpr size_t WS_XN = 40 * MiB;
constexpr size_t WS_QA = 104 * MiB;
constexpr size_t WS_KVA = 136 * MiB;
constexpr size_t WS_MQK = 152 * MiB;
constexpr size_t WS_MV = 184 * MiB;
constexpr size_t WS_MO = 216 * MiB;
constexpr size_t WS_GA = 248 * MiB;
constexpr size_t WS_GM = 312 * MiB;
constexpr size_t WS_AO = 376 * MiB;
constexpr size_t WS_HN = 408 * MiB;
constexpr size_t WS_CLOC = 440 * MiB;
constexpr size_t WS_CST = 472 * MiB;
constexpr size_t WS_END = 504 * MiB;
constexpr size_t WS_MG = WS_XN;
constexpr size_t WS_TMP = 104 * MiB;
constexpr size_t WS_X1B = 168 * MiB;
constexpr size_t WS_HB = 232 * MiB;
}

typedef unsigned short bf16;
__device__ __forceinline__ unsigned f2bf(float f) { unsigned u = __builtin_bit_cast(unsigned, f); return (u + 0x7fffu + ((u >> 16) & 1u)) >> 16; }
__device__ __forceinline__ float bf2f(bf16 h) { return __builtin_bit_cast(float, (unsigned)h << 16); }
__device__ __forceinline__ float sigmoidf_(float x) { return 1.f / (1.f + __expf(-x)); }
__device__ __forceinline__ float siluf_(float x) { return x / (1.f + __expf(-x)); }
__device__ __forceinline__ float logsigmoidf_(float z) { return fminf(z, 0.f) - log1pf(__expf(-fabsf(z))); }

namespace naive {
using namespace cfg;

__global__ void __launch_bounds__(256) k_prologue(const float* __restrict__ x, const float* __restrict__ g1, const float* __restrict__ w_in, bf16* XN, float* GATES) {
    const int lane = threadIdx.x & 63, row = blockIdx.x * 4 + (threadIdx.x >> 6);
    float v[16]; float ss = 0.f;
#pragma unroll
    for (int j = 0; j < 16; ++j) { v[j] = x[(size_t)row * D + j * 64 + lane]; ss += v[j] * v[j]; }
#pragma unroll
    for (int o = 1; o < 64; o <<= 1) ss += __shfl_xor(ss, o);
    const float r = rsqrtf(ss * (1.f / D) + EPS);
    float ga[8];
#pragma unroll
    for (int g = 0; g < 8; ++g) ga[g] = 0.f;
#pragma unroll
    for (int j = 0; j < 16; ++j) { const int k = j * 64 + lane; const float u = v[j] * r * g1[k]; XN[(size_t)row * D + k] = (bf16)f2bf(u);
#pragma unroll
        for (int g = 0; g < 8; ++g) ga[g] += u * w_in[(size_t)k * INW + C_MI + g]; }
#pragma unroll
    for (int g = 0; g < 8; ++g) {
#pragma unroll
        for (int o = 1; o < 64; o <<= 1) ga[g] += __shfl_xor(ga[g], o);
    }
    if (lane == 0) {
#pragma unroll
        for (int g = 0; g < 8; ++g) GATES[(size_t)row * 8 + g] = ga[g]; }
}

template <class AL, class BL, class EP>
__global__ void __launch_bounds__(256) k_gemm(int N, int K, AL al, BL bl, EP ep) {
    __shared__ float As[16][68], Bs[16][68];
    const int tx = threadIdx.x & 15, ty = threadIdx.x >> 4, m0 = blockIdx.y * 64, n0 = blockIdx.x * 64;
    float acc[4][4];
#pragma unroll
    for (int i = 0; i < 4; ++i)
#pragma unroll
        for (int j = 0; j < 4; ++j) acc[i][j] = 0.f;
    for (int k0 = 0; k0 < K; k0 += 16) {
#pragma unroll
        for (int q = 0; q < 4; ++q) { const int i = threadIdx.x + q * 256; const int m = i >> 4, k = i & 15; As[k][m] = al(m0 + m, k0 + k); }
#pragma unroll
        for (int q = 0; q < 4; ++q) { const int i = threadIdx.x + q * 256; const int k = i >> 6, n = i & 63; Bs[k][n] = (n0 + n < N) ? bl(k0 + k, n0 + n) : 0.f; }
        __syncthreads();
#pragma unroll
        for (int k = 0; k < 16; ++k) { float a[4], b[4];
#pragma unroll
            for (int i = 0; i < 4; ++i) { a[i] = As[k][ty * 4 + i]; b[i] = Bs[k][tx * 4 + i]; }
#pragma unroll
            for (int i = 0; i < 4; ++i)
#pragma unroll
                for (int j = 0; j < 4; ++j) acc[i][j] += a[i] * b[j]; }
        __syncthreads();
    }
#pragma unroll
    for (int i = 0; i < 4; ++i)
#pragma unroll
        for (int j = 0; j < 4; ++j) { const int col = n0 + tx * 4 + j; if (col < N) ep(m0 + ty * 4 + i, col, acc[i][j]); }
}
struct ABf16 { const bf16* A; long lda; __device__ float operator()(int m, int k) const { return bf2f(A[(size_t)m * lda + k]); } };
struct BF32 { const float* B; long ldb; __device__ float operator()(int k, int n) const { return B[(size_t)k * ldb + n]; } };
struct BF32Scaled { const float* B; long ldb; const float* g; __device__ float operator()(int k, int n) const { return B[(size_t)k * ldb + n] * g[k]; } };
struct BGateUp { const float* Wg; const float* Wu; const float* g; __device__ float operator()(int k, int n) const { return (n < FF ? Wg[(size_t)k * FF + n] : Wu[(size_t)k * FF + (n - FF)]) * g[k]; } };

struct EpG1 { unsigned char* ws;
    __device__ void operator()(int row, int col, float v) const {
        bf16* p;
        if (col < C_AK) { p = (bf16*)(ws + WS_QA) + (size_t)row * 512 + col; v *= QSCALE; }
        else if (col < C_MQK) { p = (bf16*)(ws + WS_KVA) + (size_t)row * 256 + (col - C_AK); }
        else if (col < C_MV) { p = (bf16*)(ws + WS_MQK) + (size_t)row * 512 + (col - C_MQK); }
        else if (col < C_MO) { p = (bf16*)(ws + WS_MV) + (size_t)row * 512 + (col - C_MV); }
        else if (col < C_MI) { p = (bf16*)(ws + WS_MO) + (size_t)row * 512 + (col - C_MO); v = sigmoidf_(v); }
        else if (col < C_GA) { return; }
        else if (col < C_GM) { p = (bf16*)(ws + WS_GA) + (size_t)row * 1024 + (col - C_GA); v = sigmoidf_(v); }
        else { p = (bf16*)(ws + WS_GM) + (size_t)row * 1024 + (col - C_GM); v = sigmoidf_(v); }
        *p = (bf16)f2bf(v);
    } };
struct EpG2a { const bf16* GA; bf16* TMP; __device__ void operator()(int row, int col, float v) const { const size_t o = (size_t)row * 1024 + col; TMP[o] = (bf16)f2bf(bf2f(GA[o]) * v); } };
struct EpG2b { const bf16* GM; const bf16* TMP; bf16* MG; __device__ void operator()(int row, int col, float v) const { const size_t o = (size_t)row * 1024 + col; MG[o] = (bf16)f2bf(bf2f(GM[o]) * v + bf2f(TMP[o])); } };
struct EpG3 { const float* x; float* out; bf16* X1B; __device__ void operator()(int row, int col, float v) const { const size_t o = (size_t)row * 1024 + col; const float x1 = x[o] + v; out[o] = x1; X1B[o] = (bf16)f2bf(x1); } };
struct EpG4 { const float* SS1; bf16* HB; __device__ void operator()(int row, int col, float g, float u) const { const float* s = SS1 + (size_t)row * 4; const float r = rsqrtf((s[0] + s[1] + s[2] + s[3]) * (1.f / D) + EPS);
        HB[(size_t)row * FF + col] = (bf16)f2bf(siluf_(g * r) * (u * r)); } };
struct EpG5 { float* out; __device__ void operator()(int row, int col, float v) const { out[(size_t)row * 1024 + col] += v; } };

__global__ void __launch_bounds__(256) k_ss1(const float* __restrict__ x1, float* SS1) {
    const int lane = threadIdx.x & 63, row = blockIdx.x * 4 + (threadIdx.x >> 6);
#pragma unroll
    for (int t = 0; t < 4; ++t) { float ss = 0.f;
#pragma unroll
        for (int j = 0; j < 4; ++j) { const float v = x1[(size_t)row * D + t * 256 + j * 64 + lane]; ss += v * v; }
#pragma unroll
        for (int o = 1; o < 64; o <<= 1) ss += __shfl_xor(ss, o);
        if (lane == 0) SS1[(size_t)row * 4 + t] = ss; }
}
__global__ void __launch_bounds__(256) k_final_norm(float* out, const float* __restrict__ gF) {
    const int lane = threadIdx.x & 63, row = blockIdx.x * 4 + (threadIdx.x >> 6);
    float v[16]; float ss = 0.f;
#pragma unroll
    for (int j = 0; j < 16; ++j) { v[j] = out[(size_t)row * D + j * 64 + lane]; ss += v[j] * v[j]; }
#pragma unroll
    for (int o = 1; o < 64; o <<= 1) ss += __shfl_xor(ss, o);
    const float r = rsqrtf(ss * (1.f / D) + EPS);
#pragma unroll
    for (int j = 0; j < 16; ++j) out[(size_t)row * D + j * 64 + lane] = v[j] * r * gF[j * 64 + lane];
}

__global__ void __launch_bounds__(128) k_attn(const bf16* __restrict__ QA, const bf16* __restrict__ KVA, const float* __restrict__ sinks, bf16* AO) {
    extern __shared__ unsigned short sm_attn[];
    unsigned short (*Ks)[66] = (unsigned short (*)[66])sm_attn; unsigned short (*Vs)[66] = (unsigned short (*)[66])(sm_attn + 256 * 66);
    const int nb = blockIdx.x, hq = blockIdx.y, b = blockIdx.z, hkv = hq >> 2, i = threadIdx.x;
    for (int e = threadIdx.x; e < 256 * 64; e += 128) { const int jj = e >> 6, d = e & 63; const int pos = nb * 128 - 128 + jj; unsigned short kv = 0, vv = 0;
        if (pos >= 0) { const size_t r = ((size_t)b * SEQ + pos) * 256; kv = KVA[r + hkv * 64 + d]; vv = KVA[r + 128 + hkv * 64 + d]; }
        Ks[jj][d] = kv; Vs[jj][d] = vv; }
    __syncthreads();
    const size_t row = (size_t)b * SEQ + nb * 128 + i;
    float q[64], o[64];
#pragma unroll
    for (int d = 0; d < 64; ++d) { q[d] = bf2f(QA[row * 512 + hq * 64 + d]); o[d] = 0.f; }
    const float slope2 = exp2f(-(float)(hq + 1)) * LOG2E, sink2 = sinks[hq] * LOG2E;
    float mx = sink2, l = 0.f;
    for (int dist = 127; dist >= 0; --dist) { const int jj = i + 128 - dist;
        if (nb == 0 && jj < 128) continue;
        float s = 0.f;
#pragma unroll
        for (int d = 0; d < 64; ++d) s += q[d] * bf2f(Ks[jj][d]);
        s -= slope2 * (float)dist;
        const float mn = fmaxf(mx, s), f = exp2f(mx - mn), p = exp2f(s - mn); l = l * f + p; mx = mn;
#pragma unroll
        for (int d = 0; d < 64; ++d) o[d] = o[d] * f + p * bf2f(Vs[jj][d]); }
    const float inv = 1.f / (l + exp2f(sink2 - mx));
#pragma unroll
    for (int d = 0; d < 64; ++d) AO[row * 512 + hq * 64 + d] = (bf16)f2bf(o[d] * inv);
}

constexpr int MS_GC = 0, MS_MLOC = 1024, MS_MST = 2048, MS_NLOC = 4096, MS_NST = 4096 + 65536;
__device__ __forceinline__ float conv_silu(const bf16* MQK, int b, int t, int ch, const float* cw, const float* cb) {
    float a = cb[ch];
#pragma unroll
    for (int j = 0; j < 4; ++j) { const int tt = t + j - 3; if (tt >= 0) a += cw[j * 512 + ch] * bf2f(MQK[((size_t)b * SEQ + tt) * 512 + ch]); }
    return siluf_(a);
}
__global__ void __launch_bounds__(256) k_mlstm_a(const bf16* __restrict__ MQK, const bf16* __restrict__ MV, const float* __restrict__ GATES, const float* __restrict__ cw, const float* __restrict__ cb,
                                                 const float* __restrict__ ib, const float* __restrict__ fb, float* CLOC, float* MSM) {
    extern __shared__ float sm_a[];
    float* ks = sm_a; bf16* vs = (bf16*)(sm_a + 128 * 64); float* w = sm_a + 128 * 64 + 128 * 64; float* scal = w + 128;
    const int c = blockIdx.x, h = blockIdx.y, b = blockIdx.z, tid = threadIdx.x, item = (b * 4 + h) * 32 + c, t0 = c * 128;
    for (int e = tid; e < 128 * 64; e += 256) { const int s = e >> 6, d = e & 63; ks[e] = 0.125f * conv_silu(MQK, b, t0 + s, 256 + h * 64 + d, cw, cb); }
    for (int e = tid; e < 128 * 128; e += 256) { const int s = e >> 7, v = e & 127; vs[e] = MV[((size_t)b * SEQ + t0 + s) * 512 + h * 128 + v]; }
    if (tid == 0) { float bc = 0.f;
        for (int s = 0; s < 128; ++s) { const float* g = GATES + ((size_t)b * SEQ + t0 + s) * 8; bc += logsigmoidf_(g[4 + h] + fb[h]); w[s] = g[h] + ib[h] - bc; }
        float mx = -INFINITY; for (int s = 0; s < 128; ++s) { w[s] += bc; mx = fmaxf(mx, w[s]); }
        for (int s = 0; s < 128; ++s) w[s] = __expf(w[s] - mx);
        MSM[MS_GC + item] = bc; MSM[MS_MLOC + item] = mx; }
    __syncthreads();
    { const int dv = tid & 127, dk0 = (tid >> 7) * 32; float acc[32];
#pragma unroll
        for (int j = 0; j < 32; ++j) acc[j] = 0.f;
        for (int s = 0; s < 128; ++s) { const float wv = w[s] * bf2f(vs[s * 128 + dv]);
#pragma unroll
            for (int j = 0; j < 32; ++j) acc[j] += ks[s * 64 + dk0 + j] * wv; }
#pragma unroll
        for (int j = 0; j < 32; ++j) CLOC[((size_t)item * 64 + dk0 + j) * 128 + dv] = acc[j]; }
    if (tid < 64) { float a = 0.f; for (int s = 0; s < 128; ++s) a += w[s] * ks[s * 64 + tid]; MSM[MS_NLOC + item * 64 + tid] = a; }
}
__global__ void __launch_bounds__(256) k_mlstm_b(const float* __restrict__ CLOC, float* CST, float* MSM) {
    const int bh = blockIdx.y, e = blockIdx.x * 256 + threadIdx.x; if (e >= 8192 + 64) return;
    float m = 0.f, C = 0.f;
    for (int c = 0; c < 32; ++c) { const int item = bh * 32 + c; const float G = MSM[MS_GC + item], ml = MSM[MS_MLOC + item];
        const float mn = fmaxf(G + m, ml), dec = __expf(G + m - mn), sc = __expf(ml - mn);
        if (e < 8192) { CST[(size_t)item * 8192 + e] = C; C = dec * C + sc * CLOC[(size_t)item * 8192 + e]; }
        else { const int k = e - 8192; MSM[MS_NST + item * 64 + k] = C; C = dec * C + sc * MSM[MS_NLOC + item * 64 + k]; if (k == 0) MSM[MS_MST + item] = m; }
        m = mn; }
}
__global__ void __launch_bounds__(128) k_mlstm_c(const bf16* __restrict__ MQK, const bf16* __restrict__ MV, const bf16* __restrict__ MO, const float* __restrict__ GATES, const float* __restrict__ cw, const float* __restrict__ cb,
                                                 const float* __restrict__ ib, const float* __restrict__ fb, const float* __restrict__ gmn, const float* __restrict__ CST, const float* __restrict__ MSM, bf16* HN) {
    extern __shared__ float sm_c[];
    float* ks = sm_c; bf16* vs = (bf16*)(sm_c + 8192); float* Cs = sm_c + 8192 + 8192; float* bs = Cs + 8192; float* us = bs + 128; float* ns = us + 128; float* qs = ns + 64;
    const int c = blockIdx.x, h = blockIdx.y, b = blockIdx.z, tid = threadIdx.x, item = (b * 4 + h) * 32 + c, t0 = c * 128;
    for (int e = tid; e < 128 * 64; e += 128) { const int s = e >> 6, d = e & 63; ks[e] = 0.125f * conv_silu(MQK, b, t0 + s, 256 + h * 64 + d, cw, cb); }
    for (int e = tid; e < 128 * 128; e += 128) { const int s = e >> 7, v = e & 127; vs[e] = MV[((size_t)b * SEQ + t0 + s) * 512 + h * 128 + v]; }
    for (int e = tid; e < 8192; e += 128) Cs[e] = CST[(size_t)item * 8192 + e];
    if (tid < 64) ns[tid] = MSM[MS_NST + item * 64 + tid];
    if (tid == 0) { float bc = 0.f; for (int s = 0; s < 128; ++s) { const float* g = GATES + ((size_t)b * SEQ + t0 + s) * 8; bc += logsigmoidf_(g[4 + h] + fb[h]); bs[s] = bc; us[s] = g[h] + ib[h] - bc; } }
    __syncthreads();
    const int t = tid; const float ms = MSM[MS_MST + item];
    float Mt = ms; for (int s = 0; s <= t; ++s) Mt = fmaxf(Mt, us[s]);
    const float bt = bs[t], mt = bt + Mt;
    float q[64];
#pragma unroll
    for (int d = 0; d < 64; ++d) q[d] = conv_silu(MQK, b, t0 + t, h * 64 + d, cw, cb);
    float num[128]; float nq = 0.f;
#pragma unroll
    for (int v = 0; v < 128; ++v) num[v] = 0.f;
    for (int s = 0; s < 128; ++s) { float kq = 0.f;
#pragma unroll
        for (int d = 0; d < 64; ++d) kq += q[d] * ks[s * 64 + d];
        const float wgt = (s <= t) ? __expf(us[s] - Mt) : 0.f, sc = kq * wgt; nq += sc;
#pragma unroll
        for (int v = 0; v < 128; ++v) num[v] += sc * bf2f(vs[s * 128 + v]); }
    const float wint = __expf(ms - Mt);
    { float qn = 0.f;
#pragma unroll
        for (int d = 0; d < 64; ++d) qn += q[d] * ns[d];
        nq += wint * qn; }
#pragma unroll
    for (int d = 0; d < 64; ++d) qs[t * 65 + d] = q[d];
    for (int d = 0; d < 64; ++d) { const float qd = qs[t * 65 + d] * wint;
#pragma unroll
        for (int v = 0; v < 128; ++v) num[v] += qd * Cs[d * 128 + v]; }
    const float den = 1.f / fmaxf(fabsf(nq), __expf(-mt));
    float ss = 0.f;
#pragma unroll
    for (int v = 0; v < 128; ++v) { num[v] *= den; ss += num[v] * num[v]; }
    const float r = rsqrtf(ss * (1.f / 128.f) + EPS); const size_t row = (size_t)b * SEQ + t0 + t;
#pragma unroll
    for (int v = 0; v < 128; ++v) HN[row * 512 + h * 128 + v] = (bf16)f2bf(num[v] * r * gmn[h * 128 + v] * bf2f(MO[row * 512 + h * 128 + v]));
}
template <class AL, class BL, class EP>
__global__ void __launch_bounds__(256) k_gemm_dual(int N, int K, AL al, BL bl1, BL bl2, EP ep) {
    __shared__ float As[16][68], Bs1[16][68], Bs2[16][68];
    const int tx = threadIdx.x & 15, ty = threadIdx.x >> 4, m0 = blockIdx.y * 64, n0 = blockIdx.x * 64;
    float acc1[4][4], acc2[4][4];
#pragma unroll
    for (int i = 0; i < 4; ++i)
#pragma unroll
        for (int j = 0; j < 4; ++j) { acc1[i][j] = 0.f; acc2[i][j] = 0.f; }
    for (int k0 = 0; k0 < K; k0 += 16) {
#pragma unroll
        for (int q = 0; q < 4; ++q) { const int i = threadIdx.x + q * 256; const int m = i >> 4, k = i & 15; As[k][m] = al(m0 + m, k0 + k); }
#pragma unroll
        for (int q = 0; q < 4; ++q) { const int i = threadIdx.x + q * 256; const int k = i >> 6, n = i & 63; const bool ok = n0 + n < N; Bs1[k][n] = ok ? bl1(k0 + k, n0 + n) : 0.f; Bs2[k][n] = ok ? bl2(k0 + k, n0 + n) : 0.f; }
        __syncthreads();
#pragma unroll
        for (int k = 0; k < 16; ++k) { float a[4], b1[4], b2[4];
#pragma unroll
            for (int i = 0; i < 4; ++i) { a[i] = As[k][ty * 4 + i]; b1[i] = Bs1[k][tx * 4 + i]; b2[i] = Bs2[k][tx * 4 + i]; }
#pragma unroll
            for (int i = 0; i < 4; ++i)
#pragma unroll
                for (int j = 0; j < 4; ++j) { acc1[i][j] += a[i] * b1[j]; acc2[i][j] += a[i] * b2[j]; } }
        __syncthreads();
    }
#pragma unroll
    for (int i = 0; i < 4; ++i)
#pragma unroll
        for (int j = 0; j < 4; ++j) { const int col = n0 + tx * 4 + j; if (col < N) ep(m0 + ty * 4 + i, col, acc1[i][j], acc2[i][j]); }
}
}
extern "C" void kernel_launch(void* const* d_in, const int* in_sizes, int n_in, void* d_out, int out_size, void* d_ws, size_t ws_size, hipStream_t stream) {
    using namespace cfg; using namespace naive;
    static int init = 0;
    constexpr int LDS_ATT = 2 * 256 * 66 * 2, LDS_MA = (8192 + 8192 + 128 + 8) * 4, LDS_MC = (8192 + 8192 + 8192 + 128 + 128 + 64 + 128 * 65) * 4;
    if (!init) {
        if (n_in != 17 || in_sizes[0] != M * D || out_size != M * D || ws_size < WS_END) { fprintf(stderr, "kernel_launch: unexpected shapes n_in %d in0 %d out %d ws %zu\n", n_in, in_sizes[0], out_size, ws_size); init = -1; return; }
        hipFuncSetAttribute((const void*)k_attn, hipFuncAttributeMaxDynamicSharedMemorySize, LDS_ATT);
        hipFuncSetAttribute((const void*)k_mlstm_a, hipFuncAttributeMaxDynamicSharedMemorySize, LDS_MA);
        hipFuncSetAttribute((const void*)k_mlstm_c, hipFuncAttributeMaxDynamicSharedMemorySize, LDS_MC);
        init = 1;
    }
    if (init < 0) return;
    const float* x = (const float*)d_in[0]; const float* g1 = (const float*)d_in[1]; const float* w_in = (const float*)d_in[2]; const float* cw = (const float*)d_in[3]; const float* cb = (const float*)d_in[4];
    const float* ib = (const float*)d_in[5]; const float* fb = (const float*)d_in[6]; const float* gmn = (const float*)d_in[7]; const float* sinks = (const float*)d_in[8];
    const float* Wa = (const float*)d_in[9]; const float* Wm = (const float*)d_in[10]; const float* Wo = (const float*)d_in[11]; const float* g2 = (const float*)d_in[12];
    const float* Wg = (const float*)d_in[13]; const float* Wu = (const float*)d_in[14]; const float* Wd = (const float*)d_in[15]; const float* gF = (const float*)d_in[16];
    float* out = (float*)d_out; unsigned char* ws = (unsigned char*)d_ws;
    bf16* XN = (bf16*)(ws + WS_XN); float* GATES = (float*)(ws + WS_GATES); float* SS1 = (float*)(ws + WS_SS1); float* MSM = (float*)(ws + WS_MSM);
    bf16 *QA = (bf16*)(ws + WS_QA), *KVA = (bf16*)(ws + WS_KVA), *MQK = (bf16*)(ws + WS_MQK), *MV = (bf16*)(ws + WS_MV), *MO = (bf16*)(ws + WS_MO), *GA = (bf16*)(ws + WS_GA), *GM = (bf16*)(ws + WS_GM);
    bf16 *AO = (bf16*)(ws + WS_AO), *HN = (bf16*)(ws + WS_HN), *MG = (bf16*)(ws + WS_MG), *TMP = (bf16*)(ws + WS_TMP), *X1B = (bf16*)(ws + WS_X1B), *HB = (bf16*)(ws + WS_HB);
    float *CLOC = (float*)(ws + WS_CLOC), *CST = (float*)(ws + WS_CST);
    k_prologue<<<M / 4, 256, 0, stream>>>(x, g1, w_in, XN, GATES);
    k_gemm<<<dim3((INW + 63) / 64, M / 64), 256, 0, stream>>>(INW, 1024, ABf16{XN, 1024}, BF32{w_in, INW}, EpG1{ws});
    k_attn<<<dim3(32, 8, 8), 128, LDS_ATT, stream>>>(QA, KVA, sinks, AO);
    k_mlstm_a<<<dim3(32, 4, 8), 256, LDS_MA, stream>>>(MQK, MV, GATES, cw, cb, ib, fb, CLOC, MSM);
    k_mlstm_b<<<dim3((8192 + 64 + 255) / 256, 32), 256, 0, stream>>>(CLOC, CST, MSM);
    k_mlstm_c<<<dim3(32, 4, 8), 128, LDS_MC, stream>>>(MQK, MV, MO, GATES, cw, cb, ib, fb, gmn, CST, MSM, HN);
    k_gemm<<<dim3(16, M / 64), 256, 0, stream>>>(1024, 512, ABf16{AO, 512}, BF32{Wa, 1024}, EpG2a{GA, TMP});
    k_gemm<<<dim3(16, M / 64), 256, 0, stream>>>(1024, 512, ABf16{HN, 512}, BF32{Wm, 1024}, EpG2b{GM, TMP, MG});
    k_gemm<<<dim3(16, M / 64), 256, 0, stream>>>(1024, 1024, ABf16{MG, 1024}, BF32{Wo, 1024}, EpG3{x, out, X1B});
    k_ss1<<<M / 4, 256, 0, stream>>>(out, SS1);
    k_gemm_dual<<<dim3(FF / 64, M / 64), 256, 0, stream>>>(FF, 1024, ABf16{X1B, 1024}, BF32Scaled{Wg, FF, g2}, BF32Scaled{Wu, FF, g2}, EpG4{SS1, HB});
    k_gemm<<<dim3(16, M / 64), 256, 0, stream>>>(1024, FF, ABf16{HB, FF}, BF32{Wd, 1024}, EpG5{out});
    k_final_norm<<<M / 4, 256, 0, stream>>>(out, gF);
}
```

```cpp
#include <hip/hip_runtime.h>
#include <cstdio>
#include <cstdint>

namespace cfg {
constexpr int BATCH = 8, SEQ = 4096, D = 1024, M = BATCH * SEQ, INW = 4360, FF = 2816;
constexpr int C_AQ = 0, C_AK = 512, C_AV = 640, C_MQK = 768, C_MV = 1280, C_MO = 1792, C_MI = 2304, C_MF = 2308, C_GA = 2312, C_GM = 3336;
constexpr float EPS = 1e-6f, LOG2E = 1.4426950408889634f, QSCALE = 0.125f * LOG2E;
constexpr size_t MiB = 1u << 20;
constexpr size_t WS_CTL = 0;
constexpr size_t WS_GATES = 1 * MiB;
constexpr size_t WS_SS1 = 2 * MiB;
constexpr size_t WS_MSM = 3 * MiB;
constexpr size_t WS_WIN = 8 * MiB;
constexpr size_t WS_WA = 17 * MiB, WS_WM = 18 * MiB, WS_WO = 19 * MiB, WS_WGU = 21 * MiB, WS_WD = 32 * MiB;
constexpr size_t WS_XN = 40 * MiB;
constexpr size_t WS_QA = 104 * MiB;
constexpr size_t WS_KVA = 136 * MiB;
constexpr size_t WS_MQK = 152 * MiB;
constexpr size_t WS_MV = 184 * MiB;
constexpr size_t WS_MO = 216 * MiB;
constexpr size_t WS_GA = 248 * MiB;
constexpr size_t WS_GM = 312 * MiB;
constexpr size_t WS_AO = 376 * MiB;
constexpr size_t WS_HN = 408 * MiB;
constexpr size_t WS_CLOC = 440 * MiB;
constexpr size_t WS_CST = 472 * MiB;
constexpr size_t WS_END = 504 * MiB;
constexpr size_t WS_MG = WS_XN;
constexpr size_t WS_TMP = 104 * MiB;
constexpr size_t WS_X1B = 168 * MiB;
constexpr size_t WS_HB = 232 * MiB;
}

typedef unsigned short bf16;
__device__ __forceinline__ unsigned f2bf(float f) { unsigned u = __builtin_bit_cast(unsigned, f); return (u + 0x7fffu + ((u >> 16) & 1u)) >> 16; }
__device__ __forceinline__ float bf2f(bf16 h) { return __builtin_bit_cast(float, (unsigned)h << 16); }
__device__ __forceinline__ float sigmoidf_(float x) { return 1.f / (1.f + __expf(-x)); }
__device__ __forceinline__ float siluf_(float x) { return x / (1.f + __expf(-x)); }
__device__ __forceinline__ float logsigmoidf_(float z) { return fminf(z, 0.f) - log1pf(__expf(-fabsf(z))); }


#define GAS __attribute__((address_space(1)))
#define LAS __attribute__((address_space(3)))
typedef unsigned v4u __attribute__((ext_vector_type(4)));
typedef unsigned v2u __attribute__((ext_vector_type(2)));
typedef float f32x4 __attribute__((ext_vector_type(4)));
typedef float f32x2 __attribute__((ext_vector_type(2)));
typedef float f32x16 __attribute__((ext_vector_type(16)));
typedef short bf16x8 __attribute__((ext_vector_type(8)));
typedef short s16x4 __attribute__((ext_vector_type(4)));
typedef GAS unsigned gu32;
typedef GAS unsigned long long gu64;
#define RLX_AGENT __ATOMIC_RELAXED, __HIP_MEMORY_SCOPE_AGENT
#define LDS_WAIT() asm volatile("s_waitcnt lgkmcnt(0)" ::: "memory")
#define VM_WAIT() asm volatile("s_waitcnt vmcnt(0)" ::: "memory")
__device__ __forceinline__ unsigned long long rt() { return __builtin_amdgcn_s_memrealtime(); }
__device__ __forceinline__ unsigned pk2(float lo, float hi) { return f2bf(lo) | (f2bf(hi) << 16); }
typedef __bf16 bf16x2_t __attribute__((ext_vector_type(2)));
__device__ __forceinline__ unsigned cvtpk(float lo, float hi) { f32x2 v = {lo, hi}; bf16x2_t b = __builtin_convertvector(v, bf16x2_t); return __builtin_bit_cast(unsigned, b); }
__device__ __forceinline__ float fast_sigmoid(float x) { return __builtin_amdgcn_rcpf(1.f + __builtin_amdgcn_exp2f(-cfg::LOG2E * x)); }
namespace naive {
using namespace cfg;

__global__ void __launch_bounds__(256) k_prologue(const float* __restrict__ x, const float* __restrict__ g1, const float* __restrict__ w_in, bf16* XN, float* GATES) {
    const int lane = threadIdx.x & 63, row = blockIdx.x * 4 + (threadIdx.x >> 6);
    float v[16]; float ss = 0.f;
#pragma unroll
    for (int j = 0; j < 16; ++j) { v[j] = x[(size_t)row * D + j * 64 + lane]; ss += v[j] * v[j]; }
#pragma unroll
    for (int o = 1; o < 64; o <<= 1) ss += __shfl_xor(ss, o);
    const float r = rsqrtf(ss * (1.f / D) + EPS);
    float ga[8];
#pragma unroll
    for (int g = 0; g < 8; ++g) ga[g] = 0.f;
#pragma unroll
    for (int j = 0; j < 16; ++j) { const int k = j * 64 + lane; const float u = v[j] * r * g1[k]; XN[(size_t)row * D + k] = (bf16)f2bf(u);
#pragma unroll
        for (int g = 0; g < 8; ++g) ga[g] += u * w_in[(size_t)k * INW + C_MI + g]; }
#pragma unroll
    for (int g = 0; g < 8; ++g) {
#pragma unroll
        for (int o = 1; o < 64; o <<= 1) ga[g] += __shfl_xor(ga[g], o);
    }
    if (lane == 0) {
#pragma unroll
        for (int g = 0; g < 8; ++g) GATES[(size_t)row * 8 + g] = ga[g]; }
}

template <class AL, class BL, class EP>
__global__ void __launch_bounds__(256) k_gemm(int N, int K, AL al, BL bl, EP ep) {
    __shared__ float As[16][68], Bs[16][68];
    const int tx = threadIdx.x & 15, ty = threadIdx.x >> 4, m0 = blockIdx.y * 64, n0 = blockIdx.x * 64;
    float acc[4][4];
#pragma unroll
    for (int i = 0; i < 4; ++i)
#pragma unroll
        for (int j = 0; j < 4; ++j) acc[i][j] = 0.f;
    for (int k0 = 0; k0 < K; k0 += 16) {
#pragma unroll
        for (int q = 0; q < 4; ++q) { const int i = threadIdx.x + q * 256; const int m = i >> 4, k = i & 15; As[k][m] = al(m0 + m, k0 + k); }
#pragma unroll
        for (int q = 0; q < 4; ++q) { const int i = threadIdx.x + q * 256; const int k = i >> 6, n = i & 63; Bs[k][n] = (n0 + n < N) ? bl(k0 + k, n0 + n) : 0.f; }
        __syncthreads();
#pragma unroll
        for (int k = 0; k < 16; ++k) { float a[4], b[4];
#pragma unroll
            for (int i = 0; i < 4; ++i) { a[i] = As[k][ty * 4 + i]; b[i] = Bs[k][tx * 4 + i]; }
#pragma unroll
            for (int i = 0; i < 4; ++i)
#pragma unroll
                for (int j = 0; j < 4; ++j) acc[i][j] += a[i] * b[j]; }
        __syncthreads();
    }
#pragma unroll
    for (int i = 0; i < 4; ++i)
#pragma unroll
        for (int j = 0; j < 4; ++j) { const int col = n0 + tx * 4 + j; if (col < N) ep(m0 + ty * 4 + i, col, acc[i][j]); }
}
struct ABf16 { const bf16* A; long lda; __device__ float operator()(int m, int k) const { return bf2f(A[(size_t)m * lda + k]); } };
struct BF32 { const float* B; long ldb; __device__ float operator()(int k, int n) const { return B[(size_t)k * ldb + n]; } };
struct BF32Scaled { const float* B; long ldb; const float* g; __device__ float operator()(int k, int n) const { return B[(size_t)k * ldb + n] * g[k]; } };
struct BGateUp { const float* Wg; const float* Wu; const float* g; __device__ float operator()(int k, int n) const { return (n < FF ? Wg[(size_t)k * FF + n] : Wu[(size_t)k * FF + (n - FF)]) * g[k]; } };

struct EpG1 { unsigned char* ws;
    __device__ void operator()(int row, int col, float v) const {
        bf16* p;
        if (col < C_AK) { p = (bf16*)(ws + WS_QA) + (size_t)row * 512 + col; v *= QSCALE; }
        else if (col < C_MQK) { p = (bf16*)(ws + WS_KVA) + (size_t)row * 256 + (col - C_AK); }
        else if (col < C_MV) { p = (bf16*)(ws + WS_MQK) + (size_t)row * 512 + (col - C_MQK); }
        else if (col < C_MO) { p = (bf16*)(ws + WS_MV) + (size_t)row * 512 + (col - C_MV); }
        else if (col < C_MI) { p = (bf16*)(ws + WS_MO) + (size_t)row * 512 + (col - C_MO); v = sigmoidf_(v); }
        else if (col < C_GA) { return; }
        else if (col < C_GM) { p = (bf16*)(ws + WS_GA) + (size_t)row * 1024 + (col - C_GA); v = sigmoidf_(v); }
        else { p = (bf16*)(ws + WS_GM) + (size_t)row * 1024 + (col - C_GM); v = sigmoidf_(v); }
        *p = (bf16)f2bf(v);
    } };
struct EpG2a { const bf16* GA; bf16* TMP; __device__ void operator()(int row, int col, float v) const { const size_t o = (size_t)row * 1024 + col; TMP[o] = (bf16)f2bf(bf2f(GA[o]) * v); } };
struct EpG2b { const bf16* GM; const bf16* TMP; bf16* MG; __device__ void operator()(int row, int col, float v) const { const size_t o = (size_t)row * 1024 + col; MG[o] = (bf16)f2bf(bf2f(GM[o]) * v + bf2f(TMP[o])); } };
struct EpG3 { const float* x; float* out; bf16* X1B; __device__ void operator()(int row, int col, float v) const { const size_t o = (size_t)row * 1024 + col; const float x1 = x[o] + v; out[o] = x1; X1B[o] = (bf16)f2bf(x1); } };
struct EpG4 { const float* SS1; bf16* HB; __device__ void operator()(int row, int col, float g, float u) const { const float* s = SS1 + (size_t)row * 4; const float r = rsqrtf((s[0] + s[1] + s[2] + s[3]) * (1.f / D) + EPS);
        HB[(size_t)row * FF + col] = (bf16)f2bf(siluf_(g * r) * (u * r)); } };
struct EpG5 { float* out; __device__ void operator()(int row, int col, float v) const { out[(size_t)row * 1024 + col] += v; } };

__global__ void __launch_bounds__(256) k_ss1(const float* __restrict__ x1, float* SS1) {
    const int lane = threadIdx.x & 63, row = blockIdx.x * 4 + (threadIdx.x >> 6);
#pragma unroll
    for (int t = 0; t < 4; ++t) { float ss = 0.f;
#pragma unroll
        for (int j = 0; j < 4; ++j) { const float v = x1[(size_t)row * D + t * 256 + j * 64 + lane]; ss += v * v; }
#pragma unroll
        for (int o = 1; o < 64; o <<= 1) ss += __shfl_xor(ss, o);
        if (lane == 0) SS1[(size_t)row * 4 + t] = ss; }
}
__global__ void __launch_bounds__(256) k_final_norm(float* out, const float* __restrict__ gF) {
    const int lane = threadIdx.x & 63, row = blockIdx.x * 4 + (threadIdx.x >> 6);
    float v[16]; float ss = 0.f;
#pragma unroll
    for (int j = 0; j < 16; ++j) { v[j] = out[(size_t)row * D + j * 64 + lane]; ss += v[j] * v[j]; }
#pragma unroll
    for (int o = 1; o < 64; o <<= 1) ss += __shfl_xor(ss, o);
    const float r = rsqrtf(ss * (1.f / D) + EPS);
#pragma unroll
    for (int j = 0; j < 16; ++j) out[(size_t)row * D + j * 64 + lane] = v[j] * r * gF[j * 64 + lane];
}

__global__ void __launch_bounds__(128) k_attn(const bf16* __restrict__ QA, const bf16* __restrict__ KVA, const float* __restrict__ sinks, bf16* AO) {
    extern __shared__ unsigned short sm_attn[];
    unsigned short (*Ks)[66] = (unsigned short (*)[66])sm_attn; unsigned short (*Vs)[66] = (unsigned short (*)[66])(sm_attn + 256 * 66);
    const int nb = blockIdx.x, hq = blockIdx.y, b = blockIdx.z, hkv = hq >> 2, i = threadIdx.x;
    for (int e = threadIdx.x; e < 256 * 64; e += 128) { const int jj = e >> 6, d = e & 63; const int pos = nb * 128 - 128 + jj; unsigned short kv = 0, vv = 0;
        if (pos >= 0) { const size_t r = ((size_t)b * SEQ + pos) * 256; kv = KVA[r + hkv * 64 + d]; vv = KVA[r + 128 + hkv * 64 + d]; }
        Ks[jj][d] = kv; Vs[jj][d] = vv; }
    __syncthreads();
    const size_t row = (size_t)b * SEQ + nb * 128 + i;
    float q[64], o[64];
#pragma unroll
    for (int d = 0; d < 64; ++d) { q[d] = bf2f(QA[row * 512 + hq * 64 + d]); o[d] = 0.f; }
    const float slope2 = exp2f(-(float)(hq + 1)) * LOG2E, sink2 = sinks[hq] * LOG2E;
    float mx = sink2, l = 0.f;
    for (int dist = 127; dist >= 0; --dist) { const int jj = i + 128 - dist;
        if (nb == 0 && jj < 128) continue;
        float s = 0.f;
#pragma unroll
        for (int d = 0; d < 64; ++d) s += q[d] * bf2f(Ks[jj][d]);
        s -= slope2 * (float)dist;
        const float mn = fmaxf(mx, s), f = exp2f(mx - mn), p = exp2f(s - mn); l = l * f + p; mx = mn;
#pragma unroll
        for (int d = 0; d < 64; ++d) o[d] = o[d] * f + p * bf2f(Vs[jj][d]); }
    const float inv = 1.f / (l + exp2f(sink2 - mx));
#pragma unroll
    for (int d = 0; d < 64; ++d) AO[row * 512 + hq * 64 + d] = (bf16)f2bf(o[d] * inv);
}

constexpr int MS_GC = 0, MS_MLOC = 1024, MS_MST = 2048, MS_NLOC = 4096, MS_NST = 4096 + 65536;
__device__ __forceinline__ float conv_silu(const bf16* MQK, int b, int t, int ch, const float* cw, const float* cb) {
    float a = cb[ch];
#pragma unroll
    for (int j = 0; j < 4; ++j) { const int tt = t + j - 3; if (tt >= 0) a += cw[j * 512 + ch] * bf2f(MQK[((size_t)b * SEQ + tt) * 512 + ch]); }
    return siluf_(a);
}
__global__ void __launch_bounds__(256) k_mlstm_a(const bf16* __restrict__ MQK, const bf16* __restrict__ MV, const float* __restrict__ GATES, const float* __restrict__ cw, const float* __restrict__ cb,
                                                 const float* __restrict__ ib, const float* __restrict__ fb, float* CLOC, float* MSM) {
    extern __shared__ float sm_a[];
    float* ks = sm_a; bf16* vs = (bf16*)(sm_a + 128 * 64); float* w = sm_a + 128 * 64 + 128 * 64; float* scal = w + 128;
    const int c = blockIdx.x, h = blockIdx.y, b = blockIdx.z, tid = threadIdx.x, item = (b * 4 + h) * 32 + c, t0 = c * 128;
    for (int e = tid; e < 128 * 64; e += 256) { const int s = e >> 6, d = e & 63; ks[e] = 0.125f * conv_silu(MQK, b, t0 + s, 256 + h * 64 + d, cw, cb); }
    for (int e = tid; e < 128 * 128; e += 256) { const int s = e >> 7, v = e & 127; vs[e] = MV[((size_t)b * SEQ + t0 + s) * 512 + h * 128 + v]; }
    if (tid == 0) { float bc = 0.f;
        for (int s = 0; s < 128; ++s) { const float* g = GATES + ((size_t)b * SEQ + t0 + s) * 8; bc += logsigmoidf_(g[4 + h] + fb[h]); w[s] = g[h] + ib[h] - bc; }
        float mx = -INFINITY; for (int s = 0; s < 128; ++s) { w[s] += bc; mx = fmaxf(mx, w[s]); }
        for (int s = 0; s < 128; ++s) w[s] = __expf(w[s] - mx);
        MSM[MS_GC + item] = bc; MSM[MS_MLOC + item] = mx; }
    __syncthreads();
    { const int dv = tid & 127, dk0 = (tid >> 7) * 32; float acc[32];
#pragma unroll
        for (int j = 0; j < 32; ++j) acc[j] = 0.f;
        for (int s = 0; s < 128; ++s) { const float wv = w[s] * bf2f(vs[s * 128 + dv]);
#pragma unroll
            for (int j = 0; j < 32; ++j) acc[j] += ks[s * 64 + dk0 + j] * wv; }
#pragma unroll
        for (int j = 0; j < 32; ++j) CLOC[((size_t)item * 64 + dk0 + j) * 128 + dv] = acc[j]; }
    if (tid < 64) { float a = 0.f; for (int s = 0; s < 128; ++s) a += w[s] * ks[s * 64 + tid]; MSM[MS_NLOC + item * 64 + tid] = a; }
}
__global__ void __launch_bounds__(256) k_mlstm_b(const float* __restrict__ CLOC, float* CST, float* MSM) {
    const int bh = blockIdx.y, e = blockIdx.x * 256 + threadIdx.x; if (e >= 8192 + 64) return;
    float m = 0.f, C = 0.f;
    for (int c = 0; c < 32; ++c) { const int item = bh * 32 + c; const float G = MSM[MS_GC + item], ml = MSM[MS_MLOC + item];
        const float mn = fmaxf(G + m, ml), dec = __expf(G + m - mn), sc = __expf(ml - mn);
        if (e < 8192) { CST[(size_t)item * 8192 + e] = C; C = dec * C + sc * CLOC[(size_t)item * 8192 + e]; }
        else { const int k = e - 8192; MSM[MS_NST + item * 64 + k] = C; C = dec * C + sc * MSM[MS_NLOC + item * 64 + k]; if (k == 0) MSM[MS_MST + item] = m; }
        m = mn; }
}
__global__ void __launch_bounds__(128) k_mlstm_c(const bf16* __restrict__ MQK, const bf16* __restrict__ MV, const bf16* __restrict__ MO, const float* __restrict__ GATES, const float* __restrict__ cw, const float* __restrict__ cb,
                                                 const float* __restrict__ ib, const float* __restrict__ fb, const float* __restrict__ gmn, const float* __restrict__ CST, const float* __restrict__ MSM, bf16* HN) {
    extern __shared__ float sm_c[];
    float* ks = sm_c; bf16* vs = (bf16*)(sm_c + 8192); float* Cs = sm_c + 8192 + 8192; float* bs = Cs + 8192; float* us = bs + 128; float* ns = us + 128; float* qs = ns + 64;
    const int c = blockIdx.x, h = blockIdx.y, b = blockIdx.z, tid = threadIdx.x, item = (b * 4 + h) * 32 + c, t0 = c * 128;
    for (int e = tid; e < 128 * 64; e += 128) { const int s = e >> 6, d = e & 63; ks[e] = 0.125f * conv_silu(MQK, b, t0 + s, 256 + h * 64 + d, cw, cb); }
    for (int e = tid; e < 128 * 128; e += 128) { const int s = e >> 7, v = e & 127; vs[e] = MV[((size_t)b * SEQ + t0 + s) * 512 + h * 128 + v]; }
    for (int e = tid; e < 8192; e += 128) Cs[e] = CST[(size_t)item * 8192 + e];
    if (tid < 64) ns[tid] = MSM[MS_NST + item * 64 + tid];
    if (tid == 0) { float bc = 0.f; for (int s = 0; s < 128; ++s) { const float* g = GATES + ((size_t)b * SEQ + t0 + s) * 8; bc += logsigmoidf_(g[4 + h] + fb[h]); bs[s] = bc; us[s] = g[h] + ib[h] - bc; } }
    __syncthreads();
    const int t = tid; const float ms = MSM[MS_MST + item];
    float Mt = ms; for (int s = 0; s <= t; ++s) Mt = fmaxf(Mt, us[s]);
    const float bt = bs[t], mt = bt + Mt;
    float q[64];
#pragma unroll
    for (int d = 0; d < 64; ++d) q[d] = conv_silu(MQK, b, t0 + t, h * 64 + d, cw, cb);
    float num[128]; float nq = 0.f;
#pragma unroll
    for (int v = 0; v < 128; ++v) num[v] = 0.f;
    for (int s = 0; s < 128; ++s) { float kq = 0.f;
#pragma unroll
        for (int d = 0; d < 64; ++d) kq += q[d] * ks[s * 64 + d];
        const float wgt = (s <= t) ? __expf(us[s] - Mt) : 0.f, sc = kq * wgt; nq += sc;
#pragma unroll
        for (int v = 0; v < 128; ++v) num[v] += sc * bf2f(vs[s * 128 + v]); }
    const float wint = __expf(ms - Mt);
    { float qn = 0.f;
#pragma unroll
        for (int d = 0; d < 64; ++d) qn += q[d] * ns[d];
        nq += wint * qn; }
#pragma unroll
    for (int d = 0; d < 64; ++d) qs[t * 65 + d] = q[d];
    for (int d = 0; d < 64; ++d) { const float qd = qs[t * 65 + d] * wint;
#pragma unroll
        for (int v = 0; v < 128; ++v) num[v] += qd * Cs[d * 128 + v]; }
    const float den = 1.f / fmaxf(fabsf(nq), __expf(-mt));
    float ss = 0.f;
#pragma unroll
    for (int v = 0; v < 128; ++v) { num[v] *= den; ss += num[v] * num[v]; }
    const float r = rsqrtf(ss * (1.f / 128.f) + EPS); const size_t row = (size_t)b * SEQ + t0 + t;
#pragma unroll
    for (int v = 0; v < 128; ++v) HN[row * 512 + h * 128 + v] = (bf16)f2bf(num[v] * r * gmn[h * 128 + v] * bf2f(MO[row * 512 + h * 128 + v]));
}
template <class AL, class BL, class EP>
__global__ void __launch_bounds__(256) k_gemm_dual(int N, int K, AL al, BL bl1, BL bl2, EP ep) {
    __shared__ float As[16][68], Bs1[16][68], Bs2[16][68];
    const int tx = threadIdx.x & 15, ty = threadIdx.x >> 4, m0 = blockIdx.y * 64, n0 = blockIdx.x * 64;
    float acc1[4][4], acc2[4][4];
#pragma unroll
    for (int i = 0; i < 4; ++i)
#pragma unroll
        for (int j = 0; j < 4; ++j) { acc1[i][j] = 0.f; acc2[i][j] = 0.f; }
    for (int k0 = 0; k0 < K; k0 += 16) {
#pragma unroll
        for (int q = 0; q < 4; ++q) { const int i = threadIdx.x + q * 256; const int m = i >> 4, k = i & 15; As[k][m] = al(m0 + m, k0 + k); }
#pragma unroll
        for (int q = 0; q < 4; ++q) { const int i = threadIdx.x + q * 256; const int k = i >> 6, n = i & 63; const bool ok = n0 + n < N; Bs1[k][n] = ok ? bl1(k0 + k, n0 + n) : 0.f; Bs2[k][n] = ok ? bl2(k0 + k, n0 + n) : 0.f; }
        __syncthreads();
#pragma unroll
        for (int k = 0; k < 16; ++k) { float a[4], b1[4], b2[4];
#pragma unroll
            for (int i = 0; i < 4; ++i) { a[i] = As[k][ty * 4 + i]; b1[i] = Bs1[k][tx * 4 + i]; b2[i] = Bs2[k][tx * 4 + i]; }
#pragma unroll
            for (int i = 0; i < 4; ++i)
#pragma unroll
                for (int j = 0; j < 4; ++j) { acc1[i][j] += a[i] * b1[j]; acc2[i][j] += a[i] * b2[j]; } }
        __syncthreads();
    }
#pragma unroll
    for (int i = 0; i < 4; ++i)
#pragma unroll
        for (int j = 0; j < 4; ++j) { const int col = n0 + tx * 4 + j; if (col < N) ep(m0 + ty * 4 + i, col, acc1[i][j], acc2[i][j]); }
}
}
namespace pg8 {
#define PG8_LAS __attribute__((address_space(3)))
typedef unsigned short bf16_t;
typedef short bf16x8 __attribute__((ext_vector_type(8)));
typedef float f32x4 __attribute__((ext_vector_type(4)));
typedef unsigned u32x4 __attribute__((ext_vector_type(4)));
constexpr int BM = 256, BK = 64, HALF = 128, HTB = HALF * BK * 2  , STAGE_BYTES = 8 * HTB, NXCD = 8, WGM = 8;

__host__ __device__ __forceinline__ int lds_byte(int r, int c) { const int st = (r >> 4) * 2 + (c >> 5), rr = r & 15, cc = c & 31, ob = rr * 64 + cc * 2; return st * 1024 + (ob ^ (((ob >> 9) & 1) << 5)); }
__host__ __device__ __forceinline__ void stage_rc(int b, int& R, int& C) { const int st = b / 1024, sb = b % 1024, swz = sb ^ (((sb >> 9) & 1) << 5); R = (st >> 1) * 16 + swz / 64; C = (st & 1) * 32 + (swz % 64) / 2; }
__host__ __device__ __forceinline__ int perm32(int rho) { const int n = rho >> 4, i = rho & 15; return 8 * (i >> 2) + 4 * n + (i & 3); }

struct Unit { int pm, pn, sel; };
struct Gemm { const bf16_t* A; const bf16_t* Bt; int M, N, K; const bf16_t* A2; const bf16_t* Bt2; };

struct StaticOrder {
    int nM, nN, nwg, G, c;
    __host__ __device__ void init(int M, int N, int G_, int c_) { nM = M / BM; nN = N / BM; nwg = nM * nN; G = G_; c = c_; }
    __host__ __device__ bool next(int i, Unit& u) const {
        const long L = (long)i * G + c; if (L >= nwg) return false;
        int wgid = (int)L; { const int q = nwg / NXCD, r = nwg % NXCD, xcd = wgid % NXCD, off = wgid / NXCD; wgid = (xcd < r ? xcd * (q + 1) : r * (q + 1) + (xcd - r) * q) + off; }
        const int nig = WGM * nN, gid = wgid / nig, fm = gid * WGM, gsz = (nM - fm) < WGM ? (nM - fm) : WGM;
        u.pm = fm + ((wgid % nig) % gsz); u.pn = (wgid % nig) / gsz; u.sel = 0; return true;
    }
    __device__ __forceinline__ void a_ready(const Unit&) const {}
    __device__ __forceinline__ void done(const Unit&) const {}
};

__device__ __forceinline__ unsigned cvt_pk_bf16(float lo, float hi) { unsigned r; asm volatile("v_cvt_pk_bf16_f32 %0, %1, %2" : "=v"(r) : "v"(lo), "v"(hi)); return r; }
template <class Epi, class Sched, bool ALIGN_EPI = false, bool SP2 = false>
__device__ __forceinline__ void gemm_phase(PG8_LAS unsigned char* lds, const Gemm g, const Sched& S, const Epi& E) {
    const int tid = threadIdx.x, wid = __builtin_amdgcn_readfirstlane(tid >> 6), lane = tid & 63, wr = wid >> 2, wc = wid & 3, fr = lane & 15, fq = lane >> 4;
    const int K = g.K, nt = K / BK;
    unsigned voffA[2], voffB[2];
#pragma unroll
    for (int i = 0; i < 2; ++i) { int R, C; stage_rc(tid * 16 + i * 8192, R, C); const int Rb = Epi::PERM ? ((R & ~31) + perm32(R & 31)) : R;
        voffA[i] = (unsigned)(R * K + C) * 2u; voffB[i] = (unsigned)(Rb * K + C) * 2u; }
    const size_t kstep = (size_t)(BK * 2);
    const size_t hstep = (size_t)HALF * K * 2;
    const size_t tstep = 2 * hstep;
    const unsigned ldsw = (unsigned)wid * 1024u;
    const int aoff = lds_byte(wr * 64 + fr, fq * 8), boff = lds_byte(wc * 32 + fr, fq * 8);
#define PG8_SA(b, h) (((b) * 2 + (h)) * HTB)
#define PG8_SB(b, h) ((4 + (b) * 2 + (h)) * HTB)
#define PG8_STAGE(bufoff, gbase, voff) do { _Pragma("unroll") for (int _i = 0; _i < 2; ++_i) \
        __builtin_amdgcn_global_load_lds((const unsigned*)((const char*)(gbase) + (voff)[_i]), (PG8_LAS unsigned*)(lds + (bufoff) + ldsw + _i * 8192), 16, 0, 0); } while (0)
#define PG8_LDA(dst, b, h) do { _Pragma("unroll") for (int m = 0; m < 4; ++m) _Pragma("unroll") for (int k = 0; k < 2; ++k) dst[m][k] = *(const PG8_LAS bf16x8*)(lds + PG8_SA(b, h) + aoff + m * 2048 + k * 1024); } while (0)
#define PG8_LDB(dst, b, h) do { _Pragma("unroll") for (int n = 0; n < 2; ++n) _Pragma("unroll") for (int k = 0; k < 2; ++k) dst[n][k] = *(const PG8_LAS bf16x8*)(lds + PG8_SB(b, h) + boff + n * 2048 + k * 1024); } while (0)
#define PG8_MMA(ai, bj, At, Bt) do { __builtin_amdgcn_s_setprio(1); _Pragma("unroll") for (int m = 0; m < 4; ++m) _Pragma("unroll") for (int n = 0; n < 2; ++n) _Pragma("unroll") for (int k = 0; k < 2; ++k) \
        acc[ai][bj][m][n] = __builtin_amdgcn_mfma_f32_16x16x32_bf16(Bt[n][k], At[m][k], acc[ai][bj][m][n], 0, 0, 0); __builtin_amdgcn_s_setprio(0); } while (0)
#define PG8_WAIT_V(n) asm volatile("s_waitcnt vmcnt(" #n ")" ::: "memory")
#define PG8_WAIT_L(n) asm volatile("s_waitcnt lgkmcnt(" #n ")" ::: "memory")
#define PG8_BAR __builtin_amdgcn_s_barrier()
#define PG8_SCHED __builtin_amdgcn_sched_barrier(0)
    Unit cur, nxt; int ui = 0;
    if (!S.next(0, cur)) return;
    f32x4 acc[2][2][4][2];
#pragma unroll
    for (int a = 0; a < 2; ++a)
#pragma unroll
        for (int b = 0; b < 2; ++b)
#pragma unroll
            for (int m = 0; m < 4; ++m)
#pragma unroll
                for (int n = 0; n < 2; ++n) acc[a][b][m][n] = (f32x4){0.f, 0.f, 0.f, 0.f};
    bf16x8 At[4][2], B0[2][2], B1[2][2];
    const char* cA = (const char*)(cur.sel ? g.A2 : g.A) + (size_t)cur.pm * tstep; const char* cB = (const char*)(cur.sel ? g.Bt2 : g.Bt) + (size_t)cur.pn * tstep;
    S.a_ready(cur);
    if constexpr (SP2) {
        PG8_STAGE(PG8_SB(0, 0), cB, voffB); PG8_STAGE(PG8_SB(0, 1), cB + hstep, voffB); PG8_STAGE(PG8_SA(0, 0), cA, voffA); PG8_STAGE(PG8_SA(0, 1), cA + hstep, voffA);
        if (wr == 1) PG8_BAR;
        PG8_WAIT_V(2); PG8_BAR;
        PG8_STAGE(PG8_SB(1, 0), cB + kstep, voffB); PG8_STAGE(PG8_SA(1, 0), cA + kstep, voffA); PG8_STAGE(PG8_SB(1, 1), cB + hstep + kstep, voffB);
        PG8_WAIT_V(6); PG8_BAR;
    } else {
        PG8_STAGE(PG8_SB(0, 0), cB, voffB); PG8_STAGE(PG8_SA(0, 0), cA, voffA); PG8_STAGE(PG8_SB(0, 1), cB + hstep, voffB); PG8_STAGE(PG8_SA(0, 1), cA + hstep, voffA);
        if (wr == 1) PG8_BAR;
        PG8_WAIT_V(4); PG8_BAR;
        PG8_STAGE(PG8_SB(1, 0), cB + kstep, voffB); PG8_STAGE(PG8_SA(1, 0), cA + kstep, voffA); PG8_STAGE(PG8_SB(1, 1), cB + hstep + kstep, voffB);
        PG8_WAIT_V(6); PG8_BAR;
    }
    for (;;) {
        const bool has_next = S.next(ui + 1, nxt);
        const char* nA = has_next ? (const char*)(nxt.sel ? g.A2 : g.A) + (size_t)nxt.pm * tstep : cA; const char* nB = has_next ? (const char*)(nxt.sel ? g.Bt2 : g.Bt) + (size_t)nxt.pn * tstep : cB;
        for (int t = 0; t < nt; t += 2) {
            const bool last = (t == nt - 2);
            const char* a1 = cA + (size_t)(t + 1) * kstep;
            const char* a2 = last ? nA : cA + (size_t)(t + 2) * kstep; const char* b2 = last ? nB : cB + (size_t)(t + 2) * kstep;
            const char* a3 = a2 + kstep; const char* b3 = b2 + kstep;
            if (last && has_next) S.a_ready(nxt);
            if constexpr (SP2) {
            PG8_LDB(B0, 0, 0); PG8_LDB(B1, 0, 1); PG8_SCHED; PG8_LDA(At, 0, 0); PG8_STAGE(PG8_SA(1, 1), a1 + hstep, voffA);
            PG8_WAIT_V(8); PG8_WAIT_L(0); PG8_BAR; PG8_MMA(0, 0, At, B0); PG8_MMA(0, 1, At, B1); PG8_BAR; PG8_SCHED;
            PG8_LDA(At, 0, 1); PG8_STAGE(PG8_SB(0, 0), b2, voffB); PG8_STAGE(PG8_SB(0, 1), b2 + hstep, voffB); PG8_STAGE(PG8_SA(0, 0), a2, voffA);
            PG8_WAIT_V(8); PG8_WAIT_L(0); PG8_BAR; PG8_MMA(1, 0, At, B0); PG8_MMA(1, 1, At, B1); PG8_BAR; PG8_SCHED;
            PG8_LDB(B0, 1, 0); PG8_LDB(B1, 1, 1); PG8_SCHED; PG8_LDA(At, 1, 0); PG8_STAGE(PG8_SA(0, 1), a2 + hstep, voffA);
            PG8_WAIT_V(8); PG8_WAIT_L(0); PG8_BAR; PG8_MMA(0, 0, At, B0); PG8_MMA(0, 1, At, B1); PG8_BAR; PG8_SCHED;
            PG8_LDA(At, 1, 1); PG8_STAGE(PG8_SB(1, 0), b3, voffB); PG8_STAGE(PG8_SB(1, 1), b3 + hstep, voffB); PG8_STAGE(PG8_SA(1, 0), a3, voffA);
            PG8_WAIT_V(8); PG8_WAIT_L(0); PG8_BAR; PG8_MMA(1, 0, At, B0); PG8_MMA(1, 1, At, B1); PG8_BAR; PG8_SCHED;
            } else {
            PG8_LDB(B0, 0, 0); PG8_SCHED; PG8_LDA(At, 0, 0); PG8_STAGE(PG8_SA(1, 1), a1 + hstep, voffA);
            PG8_WAIT_L(8); PG8_BAR; PG8_WAIT_L(0); PG8_MMA(0, 0, At, B0); PG8_BAR; PG8_SCHED;
            PG8_LDB(B1, 0, 1); PG8_STAGE(PG8_SB(0, 0), b2, voffB);
            PG8_BAR; PG8_WAIT_L(0); PG8_MMA(0, 1, At, B1); PG8_BAR;
            PG8_LDA(At, 0, 1); PG8_STAGE(PG8_SA(0, 0), a2, voffA);
            PG8_BAR; PG8_WAIT_L(0); PG8_MMA(1, 0, At, B0); PG8_BAR; PG8_SCHED;
            PG8_STAGE(PG8_SB(0, 1), b2 + hstep, voffB);
            PG8_WAIT_V(6); PG8_BAR; PG8_MMA(1, 1, At, B1); PG8_BAR;
            PG8_LDB(B0, 1, 0); PG8_SCHED; PG8_LDA(At, 1, 0); PG8_STAGE(PG8_SA(0, 1), a2 + hstep, voffA);
            PG8_WAIT_L(8); PG8_BAR; PG8_WAIT_L(0); PG8_MMA(0, 0, At, B0); PG8_BAR; PG8_SCHED;
            PG8_LDB(B1, 1, 1); PG8_STAGE(PG8_SB(1, 0), b3, voffB);
            PG8_BAR; PG8_WAIT_L(0); PG8_MMA(0, 1, At, B1); PG8_BAR;
            PG8_LDA(At, 1, 1); PG8_STAGE(PG8_SA(1, 0), a3, voffA);
            PG8_BAR; PG8_WAIT_L(0); PG8_MMA(1, 0, At, B0); PG8_BAR; PG8_SCHED;
            PG8_STAGE(PG8_SB(1, 1), b3 + hstep, voffB);
            PG8_WAIT_V(6); PG8_BAR; PG8_MMA(1, 1, At, B1); PG8_BAR;
            }
        }
        if constexpr (ALIGN_EPI) { if (wr == 0) PG8_BAR; }
        if constexpr (!Epi::AFTER_DRAIN) { E(acc, cur, wr, wc, fr, fq); S.done(cur); }
        if (!has_next) break;
#pragma unroll
        for (int a = 0; a < 2; ++a)
#pragma unroll
            for (int b = 0; b < 2; ++b)
#pragma unroll
                for (int m = 0; m < 4; ++m)
#pragma unroll
                    for (int n = 0; n < 2; ++n) acc[a][b][m][n] = (f32x4){0.f, 0.f, 0.f, 0.f};
        cur = nxt; cA = nA; cB = nB; ++ui;
        if constexpr (ALIGN_EPI) { if (wr == 1) PG8_BAR; }
    }
    PG8_WAIT_V(0);
    if constexpr (!ALIGN_EPI) { if (wr == 0) PG8_BAR; }
    PG8_BAR;
    if constexpr (Epi::AFTER_DRAIN) { E.fused(acc, cur, wr, wc, fr, fq, lds, wid, lane); S.done(cur); }
#undef PG8_SA
#undef PG8_SB
#undef PG8_STAGE
#undef PG8_LDA
#undef PG8_LDB
#undef PG8_MMA
#undef PG8_WAIT_V
#undef PG8_WAIT_L
#undef PG8_BAR
#undef PG8_SCHED
}
}
#define XB_TMO      128
#define XB_XCNT(j)  (256  + 64 * (j))
#define XB_XSUB(j)  (1280 + 64 * (j))
#define XB_XGEN(j)  (2304 + 64 * (j))
#define XB_TOP      3328
#define XB_TOPGEN   3392
#define XCD_BAR_WORDS 3456
#define XB_SPIN_CAP (1u << 18)

__device__ __forceinline__ unsigned xb_ld(unsigned* p)              { return __hip_atomic_load(p, __ATOMIC_RELAXED, __HIP_MEMORY_SCOPE_AGENT); }
__device__ __forceinline__ unsigned xb_add(unsigned* p, unsigned v) { return __hip_atomic_fetch_add(p, v, __ATOMIC_RELAXED, __HIP_MEMORY_SCOPE_AGENT); }
__device__ __forceinline__ unsigned xb_xcc_id() { return (unsigned)__builtin_amdgcn_s_getreg((3 << 11) | 20) & 0xFu; }
#define XB_SPIN(cond, bar) do { unsigned _sp = 0; while (cond) { __builtin_amdgcn_s_sleep(1); \
    if ((++_sp & 255u) == 0u) { if (xb_ld(&(bar)[XB_TMO])) break; if (_sp > XB_SPIN_CAP) { atomicAdd(&(bar)[XB_TMO], 1u); break; } } } } while (0)

struct XcdBarrier {
    unsigned* bar; unsigned x;
    volatile LAS unsigned* st;
};

__device__ __forceinline__ XcdBarrier xcd_barrier_post(unsigned* bar, volatile LAS unsigned* st) {
    XcdBarrier b; b.bar = bar; b.x = xb_xcc_id(); b.st = st;
    if (threadIdx.x == 0) (void)xb_add(&bar[XB_XCNT(b.x)], 1u);
    return b;
}
__device__ __forceinline__ void xcd_barrier_complete(unsigned* bar, unsigned x, unsigned& nloc, unsigned& nx) {
    const unsigned G = gridDim.x * gridDim.y * gridDim.z;
    unsigned sum, cnt, mine, sp = 0u;
    for (;;) {
        sum = 0u; cnt = 0u; mine = 0u;
#pragma unroll
        for (unsigned j = 0; j < 16; ++j) { const unsigned c = xb_ld(&bar[XB_XCNT(j)]); sum += c; cnt += (c > 0u) ? 1u : 0u; mine = (j == x) ? c : mine; }
        if (sum == G) break;
        __builtin_amdgcn_s_sleep(1);
        if ((++sp & 255u) == 0u) { if (xb_ld(&bar[XB_TMO])) break; if (sp > XB_SPIN_CAP) { atomicAdd(&bar[XB_TMO], 1u); break; } }
    }
    nloc = mine > 0u ? mine : 1u; nx = cnt > 0u ? cnt : 1u;
}

__device__ __forceinline__ void xcd_barrier(const XcdBarrier& b) {
    asm volatile("s_waitcnt vmcnt(0)" ::: "memory");
    __syncthreads();
    if (threadIdx.x == 0) {
        unsigned* bar = b.bar;
        __builtin_amdgcn_s_waitcnt(0);
        unsigned nloc = b.st[0], nx = b.st[1];
        if (nloc == 0u) { xcd_barrier_complete(bar, b.x, nloc, nx); b.st[0] = nloc; b.st[1] = nx; }
        const unsigned old = xb_add(&bar[XB_XSUB(b.x)], 1u);
        const unsigned gen = old / nloc;
        if (old + 1u == (gen + 1u) * nloc) {
            __builtin_amdgcn_fence(__ATOMIC_RELEASE, "agent");
            asm volatile("s_waitcnt vmcnt(0)" ::: "memory");
            const unsigned og = xb_add(&bar[XB_TOP], 1u);
            const unsigned tg = og / nx;
            if (og + 1u == (tg + 1u) * nx) xb_add(&bar[XB_TOPGEN], 1u);
            else XB_SPIN(xb_ld(&bar[XB_TOPGEN]) == tg, bar);
            __builtin_amdgcn_fence(__ATOMIC_ACQUIRE, "agent");
            xb_add(&bar[XB_XGEN(b.x)], 1u);
            asm volatile("s_waitcnt vmcnt(0)" ::: "memory");
        } else {
            XB_SPIN(xb_ld(&bar[XB_XGEN(b.x)]) == gen, bar);
            __builtin_amdgcn_fence(__ATOMIC_ACQUIRE, "agent");
            asm volatile("s_waitcnt vmcnt(0)" ::: "memory");
        }
    }
    __syncthreads();
}
namespace mk {
using namespace cfg;
constexpr int NWAVES = 8, NTHREADS = 512;
constexpr int RING_OFF = 0, RING_BYTES = 131072;
constexpr int LDSCTL_OFF = RING_BYTES, MISC_OFF = LDSCTL_OFF + 320;
constexpr int LDS_BYTES = 147456;
constexpr int CW_TMO = 0, CW_CODE = 1, CW_BAR = 4096, N_BAR_REGIONS = 8;
static_assert((CW_BAR + N_BAR_REGIONS * XCD_BAR_WORDS) * 4 <= (int)MiB, "CTL words inside the memset region");
constexpr size_t WS_SS1X = 4 * MiB;
enum Phase { P_PRO = 0, P_G1, P_MIX_A, P_SCAN, P_MIX_C, P_G2, P_G3, P_G4, P_G5, P_FIN, N_PHASES };

struct Args { const float* in[17]; float* out; unsigned char* ws; int ph_lo, ph_hi, li, pad; };

struct Frame {
    LAS unsigned char* lds; volatile LAS unsigned* MISC; gu32* ctl;
    int tid, lane, wave, vcu, G;
};

__device__ __forceinline__ float wave_sum(float v) {
#pragma unroll
    for (int o = 1; o < 64; o <<= 1) v += __shfl_xor(v, o);
    return v;
}

__device__ __forceinline__ void p0_transpose_item(const float* W, int ldw, int src_c0, const float* scale, bf16* WT, int K, int dst_r0, int kb, LAS float* scr, int lane) {
    const int k0 = 64 * kb;
#pragma unroll 8
    for (int i = 0; i < 32; ++i) { const int kk = 2 * i + (lane >> 5); float v = W[(size_t)(k0 + kk) * ldw + src_c0 + (lane & 31)]; if (scale) v *= scale[k0 + kk]; scr[kk * 33 + (lane & 31)] = v; }
    LDS_WAIT(); asm volatile("" ::: "memory");
    const int c = lane & 7;
#pragma unroll
    for (int j = 0; j < 4; ++j) { const int n = (lane >> 3) + 8 * j; const LAS float* s = scr + (8 * c) * 33 + n;
        v4u o; o.x = pk2(s[0 * 33], s[1 * 33]); o.y = pk2(s[2 * 33], s[3 * 33]); o.z = pk2(s[4 * 33], s[5 * 33]); o.w = pk2(s[6 * 33], s[7 * 33]);
        *(GAS v4u*)(WT + (size_t)(dst_r0 + n) * K + k0 + 8 * c) = o; }
    LDS_WAIT(); asm volatile("" ::: "memory");
}
__device__ __forceinline__ void p0_prologue(Frame& F, const Args& a) {
    LAS float* scr = (LAS float*)(F.lds + RING_OFF + F.wave * 16384);
    const int gw = F.vcu * NWAVES + F.wave, NGW = F.G * NWAVES;
    unsigned char* ws = a.ws;
    constexpr int I0 = 16 * 72, I1 = 16 * 64, I2 = 8 * 32, I3 = 8 * 32, I4 = 16 * 32, I5 = 16 * 88, I6 = 16 * 88, I7 = 44 * 32;
    constexpr int NITEMS = I0 + I1 + I2 + I3 + I4 + I5 + I6 + I7;
    for (int it = gw; it < NITEMS; it += NGW) {
        int r = it;
        if (r < I0) { const int kb = r / 72, nb = r % 72; p0_transpose_item(a.in[2], INW, 32 * nb, nullptr, (bf16*)(ws + WS_WIN), 1024, 32 * nb, kb, scr, F.lane); continue; } r -= I0;
        if (r < I1) { const int kb = r / 64, nb = r % 64; p0_transpose_item(a.in[2], INW, C_GA + 32 * nb, nullptr, (bf16*)(ws + WS_WIN), 1024, 2304 + 32 * nb, kb, scr, F.lane); continue; } r -= I1;
        if (r < I2) { const int kb = r / 32, nb = r % 32; p0_transpose_item(a.in[9], 1024, 32 * nb, nullptr, (bf16*)(ws + WS_WA), 512, 32 * nb, kb, scr, F.lane); continue; } r -= I2;
        if (r < I3) { const int kb = r / 32, nb = r % 32; p0_transpose_item(a.in[10], 1024, 32 * nb, nullptr, (bf16*)(ws + WS_WM), 512, 32 * nb, kb, scr, F.lane); continue; } r -= I3;
        if (r < I4) { const int kb = r / 32, nb = r % 32; p0_transpose_item(a.in[11], 1024, 32 * nb, nullptr, (bf16*)(ws + WS_WO), 1024, 32 * nb, kb, scr, F.lane); continue; } r -= I4;
        if (r < I5) { const int kb = r / 88, nb = r % 88, n0 = 32 * nb; p0_transpose_item(a.in[13], FF, n0, a.in[12], (bf16*)(ws + WS_WGU), 1024, 256 * (n0 >> 7) + (n0 & 127), kb, scr, F.lane); continue; } r -= I5;
        if (r < I6) { const int kb = r / 88, nb = r % 88, n0 = 32 * nb; p0_transpose_item(a.in[14], FF, n0, a.in[12], (bf16*)(ws + WS_WGU), 1024, 256 * (n0 >> 7) + 128 + (n0 & 127), kb, scr, F.lane); continue; } r -= I6;
        { const int kb = r / 32, nb = r % 32; p0_transpose_item(a.in[15], 1024, 32 * nb, nullptr, (bf16*)(ws + WS_WD), FF, 32 * nb, kb, scr, F.lane); }
    }
    const float* x = a.in[0]; const float* g1 = a.in[1]; const float* w_in = a.in[2];
    f32x4 gwa[4][4], gwb[4][4], g1v[4];
#pragma unroll
    for (int j = 0; j < 4; ++j) { g1v[j] = *(const f32x4*)(g1 + 256 * j + 4 * F.lane);
#pragma unroll
        for (int q = 0; q < 4; ++q) { const float* p = w_in + (size_t)(256 * j + 4 * F.lane + q) * INW + C_MI; gwa[j][q] = *(const f32x4*)p; gwb[j][q] = *(const f32x4*)(p + 4); } }
    bf16* XN = (bf16*)(ws + WS_XN); float* GATES = (float*)(ws + WS_GATES);
    for (int m = gw; m < M; m += NGW) {
        const GAS f32x4* xr = (const GAS f32x4*)(x + (size_t)m * D) + F.lane;
        f32x4 v[4]; float s = 0.f;
#pragma unroll
        for (int j = 0; j < 4; ++j) { v[j] = xr[64 * j]; s += (v[j].x * v[j].x + v[j].y * v[j].y) + (v[j].z * v[j].z + v[j].w * v[j].w); }
        const float r = rsqrtf(wave_sum(s) * (1.f / D) + EPS);
        GAS unsigned long long* o8 = (GAS unsigned long long*)(XN + (size_t)m * D) + F.lane;
        f32x4 ga = {0.f, 0.f, 0.f, 0.f}, gb = {0.f, 0.f, 0.f, 0.f};
#pragma unroll
        for (int j = 0; j < 4; ++j) { const f32x4 u = v[j] * r * g1v[j];
            o8[64 * j] = (unsigned long long)pk2(u.x, u.y) | ((unsigned long long)pk2(u.z, u.w) << 32);
            ga += gwa[j][0] * u.x + gwa[j][1] * u.y + gwa[j][2] * u.z + gwa[j][3] * u.w;
            gb += gwb[j][0] * u.x + gwb[j][1] * u.y + gwb[j][2] * u.z + gwb[j][3] * u.w; }
#pragma unroll
        for (int o = 1; o < 64; o <<= 1) {
#pragma unroll
            for (int e = 0; e < 4; ++e) { ga[e] += __shfl_xor(ga[e], o); gb[e] += __shfl_xor(gb[e], o); } }
        if (F.lane == 0) { *(GAS f32x4*)(GATES + (size_t)m * 8) = ga; *(GAS f32x4*)(GATES + (size_t)m * 8 + 4) = gb; }
    }
}

typedef pg8::f32x4 af4;
__device__ __forceinline__ v4u pack8(af4 v0, af4 v1) { v4u w; w.x = cvtpk(v0[0], v0[1]); w.y = cvtpk(v0[2], v0[3]); w.z = cvtpk(v1[0], v1[1]); w.w = cvtpk(v1[2], v1[3]); return w; }
__device__ __forceinline__ void unpack8(v4u w, af4& v0, af4& v1) {
    v0[0] = __builtin_bit_cast(float, w.x << 16); v0[1] = __builtin_bit_cast(float, w.x & 0xffff0000u); v0[2] = __builtin_bit_cast(float, w.y << 16); v0[3] = __builtin_bit_cast(float, w.y & 0xffff0000u);
    v1[0] = __builtin_bit_cast(float, w.z << 16); v1[1] = __builtin_bit_cast(float, w.z & 0xffff0000u); v1[2] = __builtin_bit_cast(float, w.w << 16); v1[3] = __builtin_bit_cast(float, w.w & 0xffff0000u); }
__device__ __forceinline__ af4 sig4(af4 v) { af4 o; o[0] = fast_sigmoid(v[0]); o[1] = fast_sigmoid(v[1]); o[2] = fast_sigmoid(v[2]); o[3] = fast_sigmoid(v[3]); return o; }

struct EpiG1 {
    static constexpr bool PERM = true, AFTER_DRAIN = false; unsigned char* ws;
    __device__ __forceinline__ void operator()(const af4 (&acc)[2][2][4][2], const pg8::Unit& u, int wr, int wc, int fr, int fq) const {
        const int pn = u.pn; size_t off; int ld, ct, act;
        if (pn < 2) { off = WS_QA; ld = 512; ct = pn; act = 1; } else if (pn == 2) { off = WS_KVA; ld = 256; ct = 0; act = 0; } else if (pn < 5) { off = WS_MQK; ld = 512; ct = pn - 3; act = 0; }
        else if (pn < 7) { off = WS_MV; ld = 512; ct = pn - 5; act = 0; } else if (pn < 9) { off = WS_MO; ld = 512; ct = pn - 7; act = 2; } else if (pn < 13) { off = WS_GA; ld = 1024; ct = pn - 9; act = 2; } else { off = WS_GM; ld = 1024; ct = pn - 13; act = 2; }
        bf16* base = (bf16*)(ws + off) + (size_t)(u.pm * 256 + wr * 64 + fr) * ld + ct * 256 + wc * 32 + 8 * fq;
#pragma unroll
        for (int ai = 0; ai < 2; ++ai)
#pragma unroll
            for (int m = 0; m < 4; ++m) { bf16* rowp = base + (size_t)(ai * 128 + m * 16) * ld;
#pragma unroll
                for (int bj = 0; bj < 2; ++bj) { af4 v0 = acc[ai][bj][m][0], v1 = acc[ai][bj][m][1];
                    if (act == 1) { v0 = v0 * QSCALE; v1 = v1 * QSCALE; } else if (act == 2) { v0 = sig4(v0); v1 = sig4(v1); }
                    *(v4u*)(rowp + bj * 128) = pack8(v0, v1); } }
    }
};
struct DualOrder {
    pg8::StaticOrder so;
    __device__ __forceinline__ bool next(int i, pg8::Unit& u) const { if (!so.next(i >> 1, u)) return false; u.sel = i & 1; return true; }
    __device__ __forceinline__ void a_ready(const pg8::Unit&) const {}
    __device__ __forceinline__ void done(const pg8::Unit&) const {}
};
struct EpiG2 {
    static constexpr bool PERM = true, AFTER_DRAIN = false; const bf16* GA; const bf16* GM; bf16* TMP; bf16* MG;
    __device__ __forceinline__ void operator()(const af4 (&acc)[2][2][4][2], const pg8::Unit& u, int wr, int wc, int fr, int fq) const {
        const size_t o0 = (size_t)(u.pm * 256 + wr * 64 + fr) * 1024 + u.pn * 256 + wc * 32 + 8 * fq;
#pragma unroll
        for (int ai = 0; ai < 2; ++ai)
#pragma unroll
            for (int m = 0; m < 4; ++m)
#pragma unroll
                for (int bj = 0; bj < 2; ++bj) { const size_t o = o0 + (size_t)(ai * 128 + m * 16) * 1024 + bj * 128; af4 g0, g1;
                    if (u.sel == 0) { unpack8(*(const v4u*)(GA + o), g0, g1); *(v4u*)(TMP + o) = pack8(acc[ai][bj][m][0] * g0, acc[ai][bj][m][1] * g1); }
                    else { af4 t0, t1; unpack8(*(const v4u*)(GM + o), g0, g1); unpack8(*(const v4u*)(TMP + o), t0, t1); *(v4u*)(MG + o) = pack8(acc[ai][bj][m][0] * g0 + t0, acc[ai][bj][m][1] * g1 + t1); } }
    }
};
struct EpiG3 {
    static constexpr bool PERM = true, AFTER_DRAIN = false; const float* x; float* out; bf16* X1B; float* SS;
    __device__ __forceinline__ void operator()(const af4 (&acc)[2][2][4][2], const pg8::Unit& u, int wr, int wc, int fr, int fq) const {
        const int row0 = u.pm * 256 + wr * 64 + fr; const size_t o0 = (size_t)row0 * 1024 + u.pn * 256 + wc * 32 + 8 * fq;
#pragma unroll
        for (int ai = 0; ai < 2; ++ai)
#pragma unroll
            for (int m = 0; m < 4; ++m) { float ss = 0.f;
#pragma unroll
                for (int bj = 0; bj < 2; ++bj) { const size_t o = o0 + (size_t)(ai * 128 + m * 16) * 1024 + bj * 128;
                    const af4 a0 = *(const af4*)(x + o) + acc[ai][bj][m][0], a1 = *(const af4*)(x + o + 4) + acc[ai][bj][m][1];
                    *(af4*)(out + o) = a0; *(af4*)(out + o + 4) = a1; *(v4u*)(X1B + o) = pack8(a0, a1);
                    ss += (a0[0] * a0[0] + a0[1] * a0[1]) + (a0[2] * a0[2] + a0[3] * a0[3]) + (a1[0] * a1[0] + a1[1] * a1[1]) + (a1[2] * a1[2] + a1[3] * a1[3]); }
                ss += __shfl_xor(ss, 16); ss += __shfl_xor(ss, 32);
                if (fq == 0) SS[(size_t)(row0 + ai * 128 + m * 16) * 16 + u.pn * 4 + wc] = ss; }
    }
};
struct EpiG4 {
    static constexpr bool PERM = true, AFTER_DRAIN = false; const float* SS; bf16* HB;
    __device__ __forceinline__ void operator()(const af4 (&acc)[2][2][4][2], const pg8::Unit& u, int wr, int wc, int fr, int fq) const {
        const int row0 = u.pm * 256 + wr * 64 + fr;
#pragma unroll
        for (int ai = 0; ai < 2; ++ai)
#pragma unroll
            for (int m = 0; m < 4; ++m) { const int row = row0 + ai * 128 + m * 16;
                const af4 p = *(const af4*)(SS + (size_t)row * 16 + 4 * fq); float s = (p[0] + p[1]) + (p[2] + p[3]); s += __shfl_xor(s, 16); s += __shfl_xor(s, 32);
                const float r = rsqrtf(s * (1.f / D) + EPS); af4 h0, h1;
#pragma unroll
                for (int e = 0; e < 4; ++e) { const float g0 = acc[ai][0][m][0][e] * r, g1 = acc[ai][0][m][1][e] * r; h0[e] = g0 * fast_sigmoid(g0) * (acc[ai][1][m][0][e] * r); h1[e] = g1 * fast_sigmoid(g1) * (acc[ai][1][m][1][e] * r); }
                *(v4u*)(HB + (size_t)row * FF + u.pn * 128 + wc * 32 + 8 * fq) = pack8(h0, h1); }
    }
};
struct EpiG5 {
    static constexpr bool PERM = true, AFTER_DRAIN = false; float* out;
    __device__ __forceinline__ void operator()(const af4 (&acc)[2][2][4][2], const pg8::Unit& u, int wr, int wc, int fr, int fq) const {
        const size_t o0 = (size_t)(u.pm * 256 + wr * 64 + fr) * 1024 + u.pn * 256 + wc * 32 + 8 * fq;
#pragma unroll
        for (int ai = 0; ai < 2; ++ai)
#pragma unroll
            for (int m = 0; m < 4; ++m)
#pragma unroll
                for (int bj = 0; bj < 2; ++bj) { const size_t o = o0 + (size_t)(ai * 128 + m * 16) * 1024 + bj * 128;
                    const af4 a0 = *(const af4*)(out + o) + acc[ai][bj][m][0], a1 = *(const af4*)(out + o + 4) + acc[ai][bj][m][1]; *(af4*)(out + o) = a0; *(af4*)(out + o + 4) = a1; }
    }
};
__device__ __forceinline__ void p_final_norm(Frame& F, float* out, const float* gF) {
    const int gw = F.vcu * NWAVES + F.wave, NGW = F.G * NWAVES;
    f32x4 gv[4];
#pragma unroll
    for (int j = 0; j < 4; ++j) gv[j] = *(const f32x4*)(gF + 256 * j + 4 * F.lane);
    for (int m = gw; m < M; m += NGW) { GAS f32x4* xr = (GAS f32x4*)(out + (size_t)m * D) + F.lane; f32x4 v[4]; float s = 0.f;
#pragma unroll
        for (int j = 0; j < 4; ++j) { v[j] = xr[64 * j]; s += (v[j].x * v[j].x + v[j].y * v[j].y) + (v[j].z * v[j].z + v[j].w * v[j].w); }
        const float r = rsqrtf(wave_sum(s) * (1.f / D) + EPS);
#pragma unroll
        for (int j = 0; j < 4; ++j) xr[64 * j] = v[j] * r * gv[j]; }
}

__global__ void __launch_bounds__(NTHREADS, 2) mega(Args args) {
    extern __shared__ __attribute__((aligned(16))) unsigned char lds[];
    Frame F;
    F.lds = (LAS unsigned char*)lds; F.MISC = (volatile LAS unsigned*)(F.lds + MISC_OFF);
    F.tid = threadIdx.x; F.lane = F.tid & 63; F.wave = __builtin_amdgcn_readfirstlane(F.tid >> 6);
    F.G = gridDim.x; { const int bx = blockIdx.x; F.vcu = (F.G % 8 == 0) ? (bx % 8) * (F.G / 8) + bx / 8 : bx; }
    unsigned char* ws = args.ws; F.ctl = (gu32*)(ws + WS_CTL);
    for (int u = F.tid; u < (LDS_BYTES - LDSCTL_OFF) / 4; u += NTHREADS) ((LAS unsigned*)(F.lds + LDSCTL_OFF))[u] = 0u;
    __syncthreads();
    const int lo = args.ph_lo, hi = args.ph_hi;
    XcdBarrier bar; bar.bar = (unsigned*)(F.ctl + CW_BAR) + args.li * XCD_BAR_WORDS; bar.x = 0; bar.st = nullptr;
    if (hi - lo > 1) bar = xcd_barrier_post((unsigned*)(F.ctl + CW_BAR) + args.li * XCD_BAR_WORDS, F.MISC + 8);
#define IN(k) (lo <= (k) && (k) < hi)
#define SEAM(k) do { if (IN(k) && IN((k) + 1)) xcd_barrier(bar); } while (0)
    float* out = args.out;
    if (IN(P_PRO)) { p0_prologue(F, args); SEAM(P_PRO); }
    if (IN(P_G1)) {
        pg8::Gemm g{(const bf16*)(ws + WS_XN), (const bf16*)(ws + WS_WIN), M, 4352, 1024, nullptr, nullptr}; pg8::StaticOrder S; S.init(M, 4352, F.G, (int)blockIdx.x);
        EpiG1 E{ws}; pg8::gemm_phase<EpiG1, pg8::StaticOrder, true, true>(F.lds + RING_OFF, g, S, E);
        SEAM(P_G1);
    }
    if (IN(P_MIX_A)) { SEAM(P_MIX_A); }
    if (IN(P_SCAN)) { SEAM(P_SCAN); }
    if (IN(P_MIX_C)) { SEAM(P_MIX_C); }
    if (IN(P_G2)) {
        pg8::Gemm g{(const bf16*)(ws + WS_AO), (const bf16*)(ws + WS_WA), M, 1024, 512, (const bf16*)(ws + WS_HN), (const bf16*)(ws + WS_WM)}; DualOrder S; S.so.init(M, 1024, F.G, (int)blockIdx.x);
        EpiG2 E{(const bf16*)(ws + WS_GA), (const bf16*)(ws + WS_GM), (bf16*)(ws + WS_TMP), (bf16*)(ws + WS_MG)}; pg8::gemm_phase<EpiG2, DualOrder, true, true>(F.lds + RING_OFF, g, S, E);
        SEAM(P_G2);
    }
    if (IN(P_G3)) {
        pg8::Gemm g{(const bf16*)(ws + WS_MG), (const bf16*)(ws + WS_WO), M, 1024, 1024, nullptr, nullptr}; pg8::StaticOrder S; S.init(M, 1024, F.G, (int)blockIdx.x);
        EpiG3 E{args.in[0], out, (bf16*)(ws + WS_X1B), (float*)(ws + WS_SS1X)}; pg8::gemm_phase<EpiG3, pg8::StaticOrder, true, true>(F.lds + RING_OFF, g, S, E);
        SEAM(P_G3);
    }
    if (IN(P_G4)) {
        pg8::Gemm g{(const bf16*)(ws + WS_X1B), (const bf16*)(ws + WS_WGU), M, 2 * FF, 1024, nullptr, nullptr}; pg8::StaticOrder S; S.init(M, 2 * FF, F.G, (int)blockIdx.x);
        EpiG4 E{(const float*)(ws + WS_SS1X), (bf16*)(ws + WS_HB)}; pg8::gemm_phase<EpiG4, pg8::StaticOrder, true, true>(F.lds + RING_OFF, g, S, E);
        SEAM(P_G4);
    }
    if (IN(P_G5)) {
        pg8::Gemm g{(const bf16*)(ws + WS_HB), (const bf16*)(ws + WS_WD), M, 1024, FF, nullptr, nullptr}; pg8::StaticOrder S; S.init(M, 1024, F.G, (int)blockIdx.x);
        EpiG5 E{out}; pg8::gemm_phase<EpiG5, pg8::StaticOrder, true, true>(F.lds + RING_OFF, g, S, E);
        SEAM(P_G5);
    }
    if (IN(P_FIN)) { p_final_norm(F, out, args.in[16]); }
#undef IN
#undef SEAM
}
}
static void launch_mega(const mk::Args& a0, int lo, int hi, int li, int grid, hipStream_t stream) {
    mk::Args a = a0; a.ph_lo = lo; a.ph_hi = hi; a.li = li;
    hipLaunchKernelGGL(mk::mega, dim3(grid), dim3(mk::NTHREADS), mk::LDS_BYTES, stream, a);
}
extern "C" void kernel_launch(void* const* d_in, const int* in_sizes, int n_in, void* d_out, int out_size, void* d_ws, size_t ws_size, hipStream_t stream) {
    using namespace cfg; using namespace naive;
    static int grid = 0;
    constexpr int LDS_ATT = 2 * 256 * 66 * 2, LDS_MA = (8192 + 8192 + 128 + 8) * 4, LDS_MC = (8192 + 8192 + 8192 + 128 + 128 + 64 + 128 * 65) * 4;
    if (grid == 0) {
        if (n_in != 17 || in_sizes[0] != M * D || out_size != M * D || ws_size < WS_END) { fprintf(stderr, "kernel_launch: unexpected shapes n_in %d in0 %d out %d ws %zu\n", n_in, in_sizes[0], out_size, ws_size); grid = -1; return; }
        int dev = 0, cus = 0;
        if (hipGetDevice(&dev) != hipSuccess || hipDeviceGetAttribute(&cus, hipDeviceAttributeMultiprocessorCount, dev) != hipSuccess) { grid = -1; return; }
        (void)hipFuncSetAttribute((const void*)k_attn, hipFuncAttributeMaxDynamicSharedMemorySize, LDS_ATT);
        (void)hipFuncSetAttribute((const void*)k_mlstm_a, hipFuncAttributeMaxDynamicSharedMemorySize, LDS_MA);
        (void)hipFuncSetAttribute((const void*)k_mlstm_c, hipFuncAttributeMaxDynamicSharedMemorySize, LDS_MC);
        if (hipFuncSetAttribute((const void*)mk::mega, hipFuncAttributeMaxDynamicSharedMemorySize, mk::LDS_BYTES) != hipSuccess) { fprintf(stderr, "kernel_launch: hipFuncSetAttribute failed\n"); grid = -1; return; }
        grid = cus;
    }
    if (grid < 0) return;
    const float* cw = (const float*)d_in[3]; const float* cb = (const float*)d_in[4];
    const float* ib = (const float*)d_in[5]; const float* fb = (const float*)d_in[6]; const float* gmn = (const float*)d_in[7]; const float* sinks = (const float*)d_in[8];
    unsigned char* ws = (unsigned char*)d_ws;
    float* GATES = (float*)(ws + WS_GATES); float* MSM = (float*)(ws + WS_MSM);
    bf16 *QA = (bf16*)(ws + WS_QA), *KVA = (bf16*)(ws + WS_KVA), *MQK = (bf16*)(ws + WS_MQK), *MV = (bf16*)(ws + WS_MV), *MO = (bf16*)(ws + WS_MO);
    bf16 *AO = (bf16*)(ws + WS_AO), *HN = (bf16*)(ws + WS_HN);
    float *CLOC = (float*)(ws + WS_CLOC), *CST = (float*)(ws + WS_CST);
    (void)hipMemsetAsync(ws + WS_CTL, 0, MiB, stream);
    mk::Args a{}; for (int i = 0; i < 17; ++i) a.in[i] = (const float*)d_in[i]; a.out = (float*)d_out; a.ws = ws;
    launch_mega(a, mk::P_PRO, mk::P_G1 + 1, 0, grid, stream);
    k_attn<<<dim3(32, 8, 8), 128, LDS_ATT, stream>>>(QA, KVA, sinks, AO);
    k_mlstm_a<<<dim3(32, 4, 8), 256, LDS_MA, stream>>>(MQK, MV, GATES, cw, cb, ib, fb, CLOC, MSM);
    k_mlstm_b<<<dim3((8192 + 64 + 255) / 256, 32), 256, 0, stream>>>(CLOC, CST, MSM);
    k_mlstm_c<<<dim3(32, 4, 8), 128, LDS_MC, stream>>>(MQK, MV, MO, GATES, cw, cb, ib, fb, gmn, CST, MSM, HN);
    launch_mega(a, mk::P_G2, mk::N_PHASES, 1, grid, stream);
}
```

```cpp
#include <hip/hip_runtime.h>
#include <cstdio>
#include <cstdint>

namespace cfg {
constexpr int BATCH = 8, SEQ = 4096, D = 1024, M = BATCH * SEQ, INW = 4360, FF = 2816;
constexpr int C_AQ = 0, C_AK = 512, C_AV = 640, C_MQK = 768, C_MV = 1280, C_MO = 1792, C_MI = 2304, C_MF = 2308, C_GA = 2312, C_GM = 3336;
constexpr float EPS = 1e-6f, LOG2E = 1.4426950408889634f, QSCALE = 0.125f * LOG2E;
constexpr size_t MiB = 1u << 20;
constexpr size_t WS_CTL = 0;
constexpr size_t WS_GATES = 1 * MiB;
constexpr size_t WS_SS1 = 2 * MiB;
constexpr size_t WS_MSM = 3 * MiB;
constexpr size_t WS_WIN = 8 * MiB;
constexpr size_t WS_WA = 17 * MiB, WS_WM = 18 * MiB, WS_WO = 19 * MiB, WS_WGU = 21 * MiB, WS_WD = 32 * MiB;
constexpr size_t WS_XN = 40 * MiB;
constexpr size_t WS_QA = 104 * MiB;
constexpr size_t WS_KVA = 136 * MiB;
constexpr size_t WS_MQK = 152 * MiB;
constexpr size_t WS_MV = 184 * MiB;
constexpr size_t WS_MO = 216 * MiB;
constexpr size_t WS_GA = 248 * MiB;
constexpr size_t WS_GM = 312 * MiB;
constexpr size_t WS_AO = 376 * MiB;
constexpr size_t WS_HN = 408 * MiB;
constexpr size_t WS_CLOC = 440 * MiB;
constexpr size_t WS_CST = 472 * MiB;
constexpr size_t WS_END = 504 * MiB;
constexpr size_t WS_MG = WS_XN;
constexpr size_t WS_TMP = 104 * MiB;
constexpr size_t WS_X1B = 168 * MiB;
constexpr size_t WS_HB = 232 * MiB;
}

typedef unsigned short bf16;
__device__ __forceinline__ unsigned f2bf(float f) { unsigned u = __builtin_bit_cast(unsigned, f); return (u + 0x7fffu + ((u >> 16) & 1u)) >> 16; }
__device__ __forceinline__ float bf2f(bf16 h) { return __builtin_bit_cast(float, (unsigned)h << 16); }
__device__ __forceinline__ float sigmoidf_(float x) { return 1.f / (1.f + __expf(-x)); }
__device__ __forceinline__ float siluf_(float x) { return x / (1.f + __expf(-x)); }
__device__ __forceinline__ float logsigmoidf_(float z) { return fminf(z, 0.f) - log1pf(__expf(-fabsf(z))); }


#define GAS __attribute__((address_space(1)))
#define LAS __attribute__((address_space(3)))
typedef unsigned v4u __attribute__((ext_vector_type(4)));
typedef unsigned v2u __attribute__((ext_vector_type(2)));
typedef float f32x4 __attribute__((ext_vector_type(4)));
typedef float f32x2 __attribute__((ext_vector_type(2)));
typedef float f32x16 __attribute__((ext_vector_type(16)));
typedef short bf16x8 __attribute__((ext_vector_type(8)));
typedef short s16x4 __attribute__((ext_vector_type(4)));
typedef GAS unsigned gu32;
typedef GAS unsigned long long gu64;
#define RLX_AGENT __ATOMIC_RELAXED, __HIP_MEMORY_SCOPE_AGENT
#define LDS_WAIT() asm volatile("s_waitcnt lgkmcnt(0)" ::: "memory")
#define VM_WAIT() asm volatile("s_waitcnt vmcnt(0)" ::: "memory")
__device__ __forceinline__ unsigned long long rt() { return __builtin_amdgcn_s_memrealtime(); }
__device__ __forceinline__ unsigned pk2(float lo, float hi) { return f2bf(lo) | (f2bf(hi) << 16); }
typedef __bf16 bf16x2_t __attribute__((ext_vector_type(2)));
__device__ __forceinline__ unsigned cvtpk(float lo, float hi) { f32x2 v = {lo, hi}; bf16x2_t b = __builtin_convertvector(v, bf16x2_t); return __builtin_bit_cast(unsigned, b); }
__device__ __forceinline__ float fast_sigmoid(float x) { return __builtin_amdgcn_rcpf(1.f + __builtin_amdgcn_exp2f(-cfg::LOG2E * x)); }
namespace naive {
using namespace cfg;

__global__ void __launch_bounds__(256) k_prologue(const float* __restrict__ x, const float* __restrict__ g1, const float* __restrict__ w_in, bf16* XN, float* GATES) {
    const int lane = threadIdx.x & 63, row = blockIdx.x * 4 + (threadIdx.x >> 6);
    float v[16]; float ss = 0.f;
#pragma unroll
    for (int j = 0; j < 16; ++j) { v[j] = x[(size_t)row * D + j * 64 + lane]; ss += v[j] * v[j]; }
#pragma unroll
    for (int o = 1; o < 64; o <<= 1) ss += __shfl_xor(ss, o);
    const float r = rsqrtf(ss * (1.f / D) + EPS);
    float ga[8];
#pragma unroll
    for (int g = 0; g < 8; ++g) ga[g] = 0.f;
#pragma unroll
    for (int j = 0; j < 16; ++j) { const int k = j * 64 + lane; const float u = v[j] * r * g1[k]; XN[(size_t)row * D + k] = (bf16)f2bf(u);
#pragma unroll
        for (int g = 0; g < 8; ++g) ga[g] += u * w_in[(size_t)k * INW + C_MI + g]; }
#pragma unroll
    for (int g = 0; g < 8; ++g) {
#pragma unroll
        for (int o = 1; o < 64; o <<= 1) ga[g] += __shfl_xor(ga[g], o);
    }
    if (lane == 0) {
#pragma unroll
        for (int g = 0; g < 8; ++g) GATES[(size_t)row * 8 + g] = ga[g]; }
}

template <class AL, class BL, class EP>
__global__ void __launch_bounds__(256) k_gemm(int N, int K, AL al, BL bl, EP ep) {
    __shared__ float As[16][68], Bs[16][68];
    const int tx = threadIdx.x & 15, ty = threadIdx.x >> 4, m0 = blockIdx.y * 64, n0 = blockIdx.x * 64;
    float acc[4][4];
#pragma unroll
    for (int i = 0; i < 4; ++i)
#pragma unroll
        for (int j = 0; j < 4; ++j) acc[i][j] = 0.f;
    for (int k0 = 0; k0 < K; k0 += 16) {
#pragma unroll
        for (int q = 0; q < 4; ++q) { const int i = threadIdx.x + q * 256; const int m = i >> 4, k = i & 15; As[k][m] = al(m0 + m, k0 + k); }
#pragma unroll
        for (int q = 0; q < 4; ++q) { const int i = threadIdx.x + q * 256; const int k = i >> 6, n = i & 63; Bs[k][n] = (n0 + n < N) ? bl(k0 + k, n0 + n) : 0.f; }
        __syncthreads();
#pragma unroll
        for (int k = 0; k < 16; ++k) { float a[4], b[4];
#pragma unroll
            for (int i = 0; i < 4; ++i) { a[i] = As[k][ty * 4 + i]; b[i] = Bs[k][tx * 4 + i]; }
#pragma unroll
            for (int i = 0; i < 4; ++i)
#pragma unroll
                for (int j = 0; j < 4; ++j) acc[i][j] += a[i] * b[j]; }
        __syncthreads();
    }
#pragma unroll
    for (int i = 0; i < 4; ++i)
#pragma unroll
        for (int j = 0; j < 4; ++j) { const int col = n0 + tx * 4 + j; if (col < N) ep(m0 + ty * 4 + i, col, acc[i][j]); }
}
struct ABf16 { const bf16* A; long lda; __device__ float operator()(int m, int k) const { return bf2f(A[(size_t)m * lda + k]); } };
struct BF32 { const float* B; long ldb; __device__ float operator()(int k, int n) const { return B[(size_t)k * ldb + n]; } };
struct BF32Scaled { const float* B; long ldb; const float* g; __device__ float operator()(int k, int n) const { return B[(size_t)k * ldb + n] * g[k]; } };
struct BGateUp { const float* Wg; const float* Wu; const float* g; __device__ float operator()(int k, int n) const { return (n < FF ? Wg[(size_t)k * FF + n] : Wu[(size_t)k * FF + (n - FF)]) * g[k]; } };

struct EpG1 { unsigned char* ws;
    __device__ void operator()(int row, int col, float v) const {
        bf16* p;
        if (col < C_AK) { p = (bf16*)(ws + WS_QA) + (size_t)row * 512 + col; v *= QSCALE; }
        else if (col < C_MQK) { p = (bf16*)(ws + WS_KVA) + (size_t)row * 256 + (col - C_AK); }
        else if (col < C_MV) { p = (bf16*)(ws + WS_MQK) + (size_t)row * 512 + (col - C_MQK); }
        else if (col < C_MO) { p = (bf16*)(ws + WS_MV) + (size_t)row * 512 + (col - C_MV); }
        else if (col < C_MI) { p = (bf16*)(ws + WS_MO) + (size_t)row * 512 + (col - C_MO); v = sigmoidf_(v); }
        else if (col < C_GA) { return; }
        else if (col < C_GM) { p = (bf16*)(ws + WS_GA) + (size_t)row * 1024 + (col - C_GA); v = sigmoidf_(v); }
        else { p = (bf16*)(ws + WS_GM) + (size_t)row * 1024 + (col - C_GM); v = sigmoidf_(v); }
        *p = (bf16)f2bf(v);
    } };
struct EpG2a { const bf16* GA; bf16* TMP; __device__ void operator()(int row, int col, float v) const { const size_t o = (size_t)row * 1024 + col; TMP[o] = (bf16)f2bf(bf2f(GA[o]) * v); } };
struct EpG2b { const bf16* GM; const bf16* TMP; bf16* MG; __device__ void operator()(int row, int col, float v) const { const size_t o = (size_t)row * 1024 + col; MG[o] = (bf16)f2bf(bf2f(GM[o]) * v + bf2f(TMP[o])); } };
struct EpG3 { const float* x; float* out; bf16* X1B; __device__ void operator()(int row, int col, float v) const { const size_t o = (size_t)row * 1024 + col; const float x1 = x[o] + v; out[o] = x1; X1B[o] = (bf16)f2bf(x1); } };
struct EpG4 { const float* SS1; bf16* HB; __device__ void operator()(int row, int col, float g, float u) const { const float* s = SS1 + (size_t)row * 4; const float r = rsqrtf((s[0] + s[1] + s[2] + s[3]) * (1.f / D) + EPS);
        HB[(size_t)row * FF + col] = (bf16)f2bf(siluf_(g * r) * (u * r)); } };
struct EpG5 { float* out; __device__ void operator()(int row, int col, float v) const { out[(size_t)row * 1024 + col] += v; } };

__global__ void __launch_bounds__(256) k_ss1(const float* __restrict__ x1, float* SS1) {
    const int lane = threadIdx.x & 63, row = blockIdx.x * 4 + (threadIdx.x >> 6);
#pragma unroll
    for (int t = 0; t < 4; ++t) { float ss = 0.f;
#pragma unroll
        for (int j = 0; j < 4; ++j) { const float v = x1[(size_t)row * D + t * 256 + j * 64 + lane]; ss += v * v; }
#pragma unroll
        for (int o = 1; o < 64; o <<= 1) ss += __shfl_xor(ss, o);
        if (lane == 0) SS1[(size_t)row * 4 + t] = ss; }
}
__global__ void __launch_bounds__(256) k_final_norm(float* out, const float* __restrict__ gF) {
    const int lane = threadIdx.x & 63, row = blockIdx.x * 4 + (threadIdx.x >> 6);
    float v[16]; float ss = 0.f;
#pragma unroll
    for (int j = 0; j < 16; ++j) { v[j] = out[(size_t)row * D + j * 64 + lane]; ss += v[j] * v[j]; }
#pragma unroll
    for (int o = 1; o < 64; o <<= 1) ss += __shfl_xor(ss, o);
    const float r = rsqrtf(ss * (1.f / D) + EPS);
#pragma unroll
    for (int j = 0; j < 16; ++j) out[(size_t)row * D + j * 64 + lane] = v[j] * r * gF[j * 64 + lane];
}

__global__ void __launch_bounds__(128) k_attn(const bf16* __restrict__ QA, const bf16* __restrict__ KVA, const float* __restrict__ sinks, bf16* AO) {
    extern __shared__ unsigned short sm_attn[];
    unsigned short (*Ks)[66] = (unsigned short (*)[66])sm_attn; unsigned short (*Vs)[66] = (unsigned short (*)[66])(sm_attn + 256 * 66);
    const int nb = blockIdx.x, hq = blockIdx.y, b = blockIdx.z, hkv = hq >> 2, i = threadIdx.x;
    for (int e = threadIdx.x; e < 256 * 64; e += 128) { const int jj = e >> 6, d = e & 63; const int pos = nb * 128 - 128 + jj; unsigned short kv = 0, vv = 0;
        if (pos >= 0) { const size_t r = ((size_t)b * SEQ + pos) * 256; kv = KVA[r + hkv * 64 + d]; vv = KVA[r + 128 + hkv * 64 + d]; }
        Ks[jj][d] = kv; Vs[jj][d] = vv; }
    __syncthreads();
    const size_t row = (size_t)b * SEQ + nb * 128 + i;
    float q[64], o[64];
#pragma unroll
    for (int d = 0; d < 64; ++d) { q[d] = bf2f(QA[row * 512 + hq * 64 + d]); o[d] = 0.f; }
    const float slope2 = exp2f(-(float)(hq + 1)) * LOG2E, sink2 = sinks[hq] * LOG2E;
    float mx = sink2, l = 0.f;
    for (int dist = 127; dist >= 0; --dist) { const int jj = i + 128 - dist;
        if (nb == 0 && jj < 128) continue;
        float s = 0.f;
#pragma unroll
        for (int d = 0; d < 64; ++d) s += q[d] * bf2f(Ks[jj][d]);
        s -= slope2 * (float)dist;
        const float mn = fmaxf(mx, s), f = exp2f(mx - mn), p = exp2f(s - mn); l = l * f + p; mx = mn;
#pragma unroll
        for (int d = 0; d < 64; ++d) o[d] = o[d] * f + p * bf2f(Vs[jj][d]); }
    const float inv = 1.f / (l + exp2f(sink2 - mx));
#pragma unroll
    for (int d = 0; d < 64; ++d) AO[row * 512 + hq * 64 + d] = (bf16)f2bf(o[d] * inv);
}

constexpr int MS_GC = 0, MS_MLOC = 1024, MS_MST = 2048, MS_NLOC = 4096, MS_NST = 4096 + 65536;
__device__ __forceinline__ float conv_silu(const bf16* MQK, int b, int t, int ch, const float* cw, const float* cb) {
    float a = cb[ch];
#pragma unroll
    for (int j = 0; j < 4; ++j) { const int tt = t + j - 3; if (tt >= 0) a += cw[j * 512 + ch] * bf2f(MQK[((size_t)b * SEQ + tt) * 512 + ch]); }
    return siluf_(a);
}
__global__ void __launch_bounds__(256) k_mlstm_a(const bf16* __restrict__ MQK, const bf16* __restrict__ MV, const float* __restrict__ GATES, const float* __restrict__ cw, const float* __restrict__ cb,
                                                 const float* __restrict__ ib, const float* __restrict__ fb, float* CLOC, float* MSM) {
    extern __shared__ float sm_a[];
    float* ks = sm_a; bf16* vs = (bf16*)(sm_a + 128 * 64); float* w = sm_a + 128 * 64 + 128 * 64; float* scal = w + 128;
    const int c = blockIdx.x, h = blockIdx.y, b = blockIdx.z, tid = threadIdx.x, item = (b * 4 + h) * 32 + c, t0 = c * 128;
    for (int e = tid; e < 128 * 64; e += 256) { const int s = e >> 6, d = e & 63; ks[e] = 0.125f * conv_silu(MQK, b, t0 + s, 256 + h * 64 + d, cw, cb); }
    for (int e = tid; e < 128 * 128; e += 256) { const int s = e >> 7, v = e & 127; vs[e] = MV[((size_t)b * SEQ + t0 + s) * 512 + h * 128 + v]; }
    if (tid == 0) { float bc = 0.f;
        for (int s = 0; s < 128; ++s) { const float* g = GATES + ((size_t)b * SEQ + t0 + s) * 8; bc += logsigmoidf_(g[4 + h] + fb[h]); w[s] = g[h] + ib[h] - bc; }
        float mx = -INFINITY; for (int s = 0; s < 128; ++s) { w[s] += bc; mx = fmaxf(mx, w[s]); }
        for (int s = 0; s < 128; ++s) w[s] = __expf(w[s] - mx);
        MSM[MS_GC + item] = bc; MSM[MS_MLOC + item] = mx; }
    __syncthreads();
    { const int dv = tid & 127, dk0 = (tid >> 7) * 32; float acc[32];
#pragma unroll
        for (int j = 0; j < 32; ++j) acc[j] = 0.f;
        for (int s = 0; s < 128; ++s) { const float wv = w[s] * bf2f(vs[s * 128 + dv]);
#pragma unroll
            for (int j = 0; j < 32; ++j) acc[j] += ks[s * 64 + dk0 + j] * wv; }
#pragma unroll
        for (int j = 0; j < 32; ++j) CLOC[((size_t)item * 64 + dk0 + j) * 128 + dv] = acc[j]; }
    if (tid < 64) { float a = 0.f; for (int s = 0; s < 128; ++s) a += w[s] * ks[s * 64 + tid]; MSM[MS_NLOC + item * 64 + tid] = a; }
}
__global__ void __launch_bounds__(256) k_mlstm_b(const float* __restrict__ CLOC, float* CST, float* MSM) {
    const int bh = blockIdx.y, e = blockIdx.x * 256 + threadIdx.x; if (e >= 8192 + 64) return;
    float m = 0.f, C = 0.f;
    for (int c = 0; c < 32; ++c) { const int item = bh * 32 + c; const float G = MSM[MS_GC + item], ml = MSM[MS_MLOC + item];
        const float mn = fmaxf(G + m, ml), dec = __expf(G + m - mn), sc = __expf(ml - mn);
        if (e < 8192) { CST[(size_t)item * 8192 + e] = C; C = dec * C + sc * CLOC[(size_t)item * 8192 + e]; }
        else { const int k = e - 8192; MSM[MS_NST + item * 64 + k] = C; C = dec * C + sc * MSM[MS_NLOC + item * 64 + k]; if (k == 0) MSM[MS_MST + item] = m; }
        m = mn; }
}
__global__ void __launch_bounds__(128) k_mlstm_c(const bf16* __restrict__ MQK, const bf16* __restrict__ MV, const bf16* __restrict__ MO, const float* __restrict__ GATES, const float* __restrict__ cw, const float* __restrict__ cb,
                                                 const float* __restrict__ ib, const float* __restrict__ fb, const float* __restrict__ gmn, const float* __restrict__ CST, const float* __restrict__ MSM, bf16* HN) {
    extern __shared__ float sm_c[];
    float* ks = sm_c; bf16* vs = (bf16*)(sm_c + 8192); float* Cs = sm_c + 8192 + 8192; float* bs = Cs + 8192; float* us = bs + 128; float* ns = us + 128; float* qs = ns + 64;
    const int c = blockIdx.x, h = blockIdx.y, b = blockIdx.z, tid = threadIdx.x, item = (b * 4 + h) * 32 + c, t0 = c * 128;
    for (int e = tid; e < 128 * 64; e += 128) { const int s = e >> 6, d = e & 63; ks[e] = 0.125f * conv_silu(MQK, b, t0 + s, 256 + h * 64 + d, cw, cb); }
    for (int e = tid; e < 128 * 128; e += 128) { const int s = e >> 7, v = e & 127; vs[e] = MV[((size_t)b * SEQ + t0 + s) * 512 + h * 128 + v]; }
    for (int e = tid; e < 8192; e += 128) Cs[e] = CST[(size_t)item * 8192 + e];
    if (tid < 64) ns[tid] = MSM[MS_NST + item * 64 + tid];
    if (tid == 0) { float bc = 0.f; for (int s = 0; s < 128; ++s) { const float* g = GATES + ((size_t)b * SEQ + t0 + s) * 8; bc += logsigmoidf_(g[4 + h] + fb[h]); bs[s] = bc; us[s] = g[h] + ib[h] - bc; } }
    __syncthreads();
    const int t = tid; const float ms = MSM[MS_MST + item];
    float Mt = ms; for (int s = 0; s <= t; ++s) Mt = fmaxf(Mt, us[s]);
    const float bt = bs[t], mt = bt + Mt;
    float q[64];
#pragma unroll
    for (int d = 0; d < 64; ++d) q[d] = conv_silu(MQK, b, t0 + t, h * 64 + d, cw, cb);
    float num[128]; float nq = 0.f;
#pragma unroll
    for (int v = 0; v < 128; ++v) num[v] = 0.f;
    for (int s = 0; s < 128; ++s) { float kq = 0.f;
#pragma unroll
        for (int d = 0; d < 64; ++d) kq += q[d] * ks[s * 64 + d];
        const float wgt = (s <= t) ? __expf(us[s] - Mt) : 0.f, sc = kq * wgt; nq += sc;
#pragma unroll
        for (int v = 0; v < 128; ++v) num[v] += sc * bf2f(vs[s * 128 + v]); }
    const float wint = __expf(ms - Mt);
    { float qn = 0.f;
#pragma unroll
        for (int d = 0; d < 64; ++d) qn += q[d] * ns[d];
        nq += wint * qn; }
#pragma unroll
    for (int d = 0; d < 64; ++d) qs[t * 65 + d] = q[d];
    for (int d = 0; d < 64; ++d) { const float qd = qs[t * 65 + d] * wint;
#pragma unroll
        for (int v = 0; v < 128; ++v) num[v] += qd * Cs[d * 128 + v]; }
    const float den = 1.f / fmaxf(fabsf(nq), __expf(-mt));
    float ss = 0.f;
#pragma unroll
    for (int v = 0; v < 128; ++v) { num[v] *= den; ss += num[v] * num[v]; }
    const float r = rsqrtf(ss * (1.f / 128.f) + EPS); const size_t row = (size_t)b * SEQ + t0 + t;
#pragma unroll
    for (int v = 0; v < 128; ++v) HN[row * 512 + h * 128 + v] = (bf16)f2bf(num[v] * r * gmn[h * 128 + v] * bf2f(MO[row * 512 + h * 128 + v]));
}
template <class AL, class BL, class EP>
__global__ void __launch_bounds__(256) k_gemm_dual(int N, int K, AL al, BL bl1, BL bl2, EP ep) {
    __shared__ float As[16][68], Bs1[16][68], Bs2[16][68];
    const int tx = threadIdx.x & 15, ty = threadIdx.x >> 4, m0 = blockIdx.y * 64, n0 = blockIdx.x * 64;
    float acc1[4][4], acc2[4][4];
#pragma unroll
    for (int i = 0; i < 4; ++i)
#pragma unroll
        for (int j = 0; j < 4; ++j) { acc1[i][j] = 0.f; acc2[i][j] = 0.f; }
    for (int k0 = 0; k0 < K; k0 += 16) {
#pragma unroll
        for (int q = 0; q < 4; ++q) { const int i = threadIdx.x + q * 256; const int m = i >> 4, k = i & 15; As[k][m] = al(m0 + m, k0 + k); }
#pragma unroll
        for (int q = 0; q < 4; ++q) { const int i = threadIdx.x + q * 256; const int k = i >> 6, n = i & 63; const bool ok = n0 + n < N; Bs1[k][n] = ok ? bl1(k0 + k, n0 + n) : 0.f; Bs2[k][n] = ok ? bl2(k0 + k, n0 + n) : 0.f; }
        __syncthreads();
#pragma unroll
        for (int k = 0; k < 16; ++k) { float a[4], b1[4], b2[4];
#pragma unroll
            for (int i = 0; i < 4; ++i) { a[i] = As[k][ty * 4 + i]; b1[i] = Bs1[k][tx * 4 + i]; b2[i] = Bs2[k][tx * 4 + i]; }
#pragma unroll
            for (int i = 0; i < 4; ++i)
#pragma unroll
                for (int j = 0; j < 4; ++j) { acc1[i][j] += a[i] * b1[j]; acc2[i][j] += a[i] * b2[j]; } }
        __syncthreads();
    }
#pragma unroll
    for (int i = 0; i < 4; ++i)
#pragma unroll
        for (int j = 0; j < 4; ++j) { const int col = n0 + tx * 4 + j; if (col < N) ep(m0 + ty * 4 + i, col, acc1[i][j], acc2[i][j]); }
}
}
namespace pg8 {
#define PG8_LAS __attribute__((address_space(3)))
typedef unsigned short bf16_t;
typedef short bf16x8 __attribute__((ext_vector_type(8)));
typedef float f32x4 __attribute__((ext_vector_type(4)));
typedef unsigned u32x4 __attribute__((ext_vector_type(4)));
constexpr int BM = 256, BK = 64, HALF = 128, HTB = HALF * BK * 2  , STAGE_BYTES = 8 * HTB, NXCD = 8, WGM = 8;

__host__ __device__ __forceinline__ int lds_byte(int r, int c) { const int st = (r >> 4) * 2 + (c >> 5), rr = r & 15, cc = c & 31, ob = rr * 64 + cc * 2; return st * 1024 + (ob ^ (((ob >> 9) & 1) << 5)); }
__host__ __device__ __forceinline__ void stage_rc(int b, int& R, int& C) { const int st = b / 1024, sb = b % 1024, swz = sb ^ (((sb >> 9) & 1) << 5); R = (st >> 1) * 16 + swz / 64; C = (st & 1) * 32 + (swz % 64) / 2; }
__host__ __device__ __forceinline__ int perm32(int rho) { const int n = rho >> 4, i = rho & 15; return 8 * (i >> 2) + 4 * n + (i & 3); }

struct Unit { int pm, pn, sel; };
struct Gemm { const bf16_t* A; const bf16_t* Bt; int M, N, K; const bf16_t* A2; const bf16_t* Bt2; };

struct StaticOrder {
    int nM, nN, nwg, G, c;
    __host__ __device__ void init(int M, int N, int G_, int c_) { nM = M / BM; nN = N / BM; nwg = nM * nN; G = G_; c = c_; }
    __host__ __device__ bool next(int i, Unit& u) const {
        const long L = (long)i * G + c; if (L >= nwg) return false;
        int wgid = (int)L; { const int q = nwg / NXCD, r = nwg % NXCD, xcd = wgid % NXCD, off = wgid / NXCD; wgid = (xcd < r ? xcd * (q + 1) : r * (q + 1) + (xcd - r) * q) + off; }
        const int nig = WGM * nN, gid = wgid / nig, fm = gid * WGM, gsz = (nM - fm) < WGM ? (nM - fm) : WGM;
        u.pm = fm + ((wgid % nig) % gsz); u.pn = (wgid % nig) / gsz; u.sel = 0; return true;
    }
    __device__ __forceinline__ void a_ready(const Unit&) const {}
    __device__ __forceinline__ void done(const Unit&) const {}
};

__device__ __forceinline__ unsigned cvt_pk_bf16(float lo, float hi) { unsigned r; asm volatile("v_cvt_pk_bf16_f32 %0, %1, %2" : "=v"(r) : "v"(lo), "v"(hi)); return r; }
template <class Epi, class Sched, bool ALIGN_EPI = false, bool SP2 = false>
__device__ __forceinline__ void gemm_phase(PG8_LAS unsigned char* lds, const Gemm g, const Sched& S, const Epi& E) {
    const int tid = threadIdx.x, wid = __builtin_amdgcn_readfirstlane(tid >> 6), lane = tid & 63, wr = wid >> 2, wc = wid & 3, fr = lane & 15, fq = lane >> 4;
    const int K = g.K, nt = K / BK;
    unsigned voffA[2], voffB[2];
#pragma unroll
    for (int i = 0; i < 2; ++i) { int R, C; stage_rc(tid * 16 + i * 8192, R, C); const int Rb = Epi::PERM ? ((R & ~31) + perm32(R & 31)) : R;
        voffA[i] = (unsigned)(R * K + C) * 2u; voffB[i] = (unsigned)(Rb * K + C) * 2u; }
    const size_t kstep = (size_t)(BK * 2);
    const size_t hstep = (size_t)HALF * K * 2;
    const size_t tstep = 2 * hstep;
    const unsigned ldsw = (unsigned)wid * 1024u;
    const int aoff = lds_byte(wr * 64 + fr, fq * 8), boff = lds_byte(wc * 32 + fr, fq * 8);
#define PG8_SA(b, h) (((b) * 2 + (h)) * HTB)
#define PG8_SB(b, h) ((4 + (b) * 2 + (h)) * HTB)
#define PG8_STAGE(bufoff, gbase, voff) do { _Pragma("unroll") for (int _i = 0; _i < 2; ++_i) \
        __builtin_amdgcn_global_load_lds((const unsigned*)((const char*)(gbase) + (voff)[_i]), (PG8_LAS unsigned*)(lds + (bufoff) + ldsw + _i * 8192), 16, 0, 0); } while (0)
#define PG8_LDA(dst, b, h) do { _Pragma("unroll") for (int m = 0; m < 4; ++m) _Pragma("unroll") for (int k = 0; k < 2; ++k) dst[m][k] = *(const PG8_LAS bf16x8*)(lds + PG8_SA(b, h) + aoff + m * 2048 + k * 1024); } while (0)
#define PG8_LDB(dst, b, h) do { _Pragma("unroll") for (int n = 0; n < 2; ++n) _Pragma("unroll") for (int k = 0; k < 2; ++k) dst[n][k] = *(const PG8_LAS bf16x8*)(lds + PG8_SB(b, h) + boff + n * 2048 + k * 1024); } while (0)
#define PG8_MMA(ai, bj, At, Bt) do { __builtin_amdgcn_s_setprio(1); _Pragma("unroll") for (int m = 0; m < 4; ++m) _Pragma("unroll") for (int n = 0; n < 2; ++n) _Pragma("unroll") for (int k = 0; k < 2; ++k) \
        acc[ai][bj][m][n] = __builtin_amdgcn_mfma_f32_16x16x32_bf16(Bt[n][k], At[m][k], acc[ai][bj][m][n], 0, 0, 0); __builtin_amdgcn_s_setprio(0); } while (0)
#define PG8_WAIT_V(n) asm volatile("s_waitcnt vmcnt(" #n ")" ::: "memory")
#define PG8_WAIT_L(n) asm volatile("s_waitcnt lgkmcnt(" #n ")" ::: "memory")
#define PG8_BAR __builtin_amdgcn_s_barrier()
#define PG8_SCHED __builtin_amdgcn_sched_barrier(0)
    Unit cur, nxt; int ui = 0;
    if (!S.next(0, cur)) return;
    f32x4 acc[2][2][4][2];
#pragma unroll
    for (int a = 0; a < 2; ++a)
#pragma unroll
        for (int b = 0; b < 2; ++b)
#pragma unroll
            for (int m = 0; m < 4; ++m)
#pragma unroll
                for (int n = 0; n < 2; ++n) acc[a][b][m][n] = (f32x4){0.f, 0.f, 0.f, 0.f};
    bf16x8 At[4][2], B0[2][2], B1[2][2];
    const char* cA = (const char*)(cur.sel ? g.A2 : g.A) + (size_t)cur.pm * tstep; const char* cB = (const char*)(cur.sel ? g.Bt2 : g.Bt) + (size_t)cur.pn * tstep;
    S.a_ready(cur);
    if constexpr (SP2) {
        PG8_STAGE(PG8_SB(0, 0), cB, voffB); PG8_STAGE(PG8_SB(0, 1), cB + hstep, voffB); PG8_STAGE(PG8_SA(0, 0), cA, voffA); PG8_STAGE(PG8_SA(0, 1), cA + hstep, voffA);
        if (wr == 1) PG8_BAR;
        PG8_WAIT_V(2); PG8_BAR;
        PG8_STAGE(PG8_SB(1, 0), cB + kstep, voffB); PG8_STAGE(PG8_SA(1, 0), cA + kstep, voffA); PG8_STAGE(PG8_SB(1, 1), cB + hstep + kstep, voffB);
        PG8_WAIT_V(6); PG8_BAR;
    } else {
        PG8_STAGE(PG8_SB(0, 0), cB, voffB); PG8_STAGE(PG8_SA(0, 0), cA, voffA); PG8_STAGE(PG8_SB(0, 1), cB + hstep, voffB); PG8_STAGE(PG8_SA(0, 1), cA + hstep, voffA);
        if (wr == 1) PG8_BAR;
        PG8_WAIT_V(4); PG8_BAR;
        PG8_STAGE(PG8_SB(1, 0), cB + kstep, voffB); PG8_STAGE(PG8_SA(1, 0), cA + kstep, voffA); PG8_STAGE(PG8_SB(1, 1), cB + hstep + kstep, voffB);
        PG8_WAIT_V(6); PG8_BAR;
    }
    for (;;) {
        const bool has_next = S.next(ui + 1, nxt);
        const char* nA = has_next ? (const char*)(nxt.sel ? g.A2 : g.A) + (size_t)nxt.pm * tstep : cA; const char* nB = has_next ? (const char*)(nxt.sel ? g.Bt2 : g.Bt) + (size_t)nxt.pn * tstep : cB;
        for (int t = 0; t < nt; t += 2) {
            const bool last = (t == nt - 2);
            const char* a1 = cA + (size_t)(t + 1) * kstep;
            const char* a2 = last ? nA : cA + (size_t)(t + 2) * kstep; const char* b2 = last ? nB : cB + (size_t)(t + 2) * kstep;
            const char* a3 = a2 + kstep; const char* b3 = b2 + kstep;
            if (last && has_next) S.a_ready(nxt);
            if constexpr (SP2) {
            PG8_LDB(B0, 0, 0); PG8_LDB(B1, 0, 1); PG8_SCHED; PG8_LDA(At, 0, 0); PG8_STAGE(PG8_SA(1, 1), a1 + hstep, voffA);
            PG8_WAIT_V(8); PG8_WAIT_L(0); PG8_BAR; PG8_MMA(0, 0, At, B0); PG8_MMA(0, 1, At, B1); PG8_BAR; PG8_SCHED;
            PG8_LDA(At, 0, 1); PG8_STAGE(PG8_SB(0, 0), b2, voffB); PG8_STAGE(PG8_SB(0, 1), b2 + hstep, voffB); PG8_STAGE(PG8_SA(0, 0), a2, voffA);
            PG8_WAIT_V(8); PG8_WAIT_L(0); PG8_BAR; PG8_MMA(1, 0, At, B0); PG8_MMA(1, 1, At, B1); PG8_BAR; PG8_SCHED;
            PG8_LDB(B0, 1, 0); PG8_LDB(B1, 1, 1); PG8_SCHED; PG8_LDA(At, 1, 0); PG8_STAGE(PG8_SA(0, 1), a2 + hstep, voffA);
            PG8_WAIT_V(8); PG8_WAIT_L(0); PG8_BAR; PG8_MMA(0, 0, At, B0); PG8_MMA(0, 1, At, B1); PG8_BAR; PG8_SCHED;
            PG8_LDA(At, 1, 1); PG8_STAGE(PG8_SB(1, 0), b3, voffB); PG8_STAGE(PG8_SB(1, 1), b3 + hstep, voffB); PG8_STAGE(PG8_SA(1, 0), a3, voffA);
            PG8_WAIT_V(8); PG8_WAIT_L(0); PG8_BAR; PG8_MMA(1, 0, At, B0); PG8_MMA(1, 1, At, B1); PG8_BAR; PG8_SCHED;
            } else {
            PG8_LDB(B0, 0, 0); PG8_SCHED; PG8_LDA(At, 0, 0); PG8_STAGE(PG8_SA(1, 1), a1 + hstep, voffA);
            PG8_WAIT_L(8); PG8_BAR; PG8_WAIT_L(0); PG8_MMA(0, 0, At, B0); PG8_BAR; PG8_SCHED;
            PG8_LDB(B1, 0, 1); PG8_STAGE(PG8_SB(0, 0), b2, voffB);
            PG8_BAR; PG8_WAIT_L(0); PG8_MMA(0, 1, At, B1); PG8_BAR;
            PG8_LDA(At, 0, 1); PG8_STAGE(PG8_SA(0, 0), a2, voffA);
            PG8_BAR; PG8_WAIT_L(0); PG8_MMA(1, 0, At, B0); PG8_BAR; PG8_SCHED;
            PG8_STAGE(PG8_SB(0, 1), b2 + hstep, voffB);
            PG8_WAIT_V(6); PG8_BAR; PG8_MMA(1, 1, At, B1); PG8_BAR;
            PG8_LDB(B0, 1, 0); PG8_SCHED; PG8_LDA(At, 1, 0); PG8_STAGE(PG8_SA(0, 1), a2 + hstep, voffA);
            PG8_WAIT_L(8); PG8_BAR; PG8_WAIT_L(0); PG8_MMA(0, 0, At, B0); PG8_BAR; PG8_SCHED;
            PG8_LDB(B1, 1, 1); PG8_STAGE(PG8_SB(1, 0), b3, voffB);
            PG8_BAR; PG8_WAIT_L(0); PG8_MMA(0, 1, At, B1); PG8_BAR;
            PG8_LDA(At, 1, 1); PG8_STAGE(PG8_SA(1, 0), a3, voffA);
            PG8_BAR; PG8_WAIT_L(0); PG8_MMA(1, 0, At, B0); PG8_BAR; PG8_SCHED;
            PG8_STAGE(PG8_SB(1, 1), b3 + hstep, voffB);
            PG8_WAIT_V(6); PG8_BAR; PG8_MMA(1, 1, At, B1); PG8_BAR;
            }
        }
        if constexpr (ALIGN_EPI) { if (wr == 0) PG8_BAR; }
        if constexpr (!Epi::AFTER_DRAIN) { E(acc, cur, wr, wc, fr, fq); S.done(cur); }
        if (!has_next) break;
#pragma unroll
        for (int a = 0; a < 2; ++a)
#pragma unroll
            for (int b = 0; b < 2; ++b)
#pragma unroll
                for (int m = 0; m < 4; ++m)
#pragma unroll
                    for (int n = 0; n < 2; ++n) acc[a][b][m][n] = (f32x4){0.f, 0.f, 0.f, 0.f};
        cur = nxt; cA = nA; cB = nB; ++ui;
        if constexpr (ALIGN_EPI) { if (wr == 1) PG8_BAR; }
    }
    PG8_WAIT_V(0);
    if constexpr (!ALIGN_EPI) { if (wr == 0) PG8_BAR; }
    PG8_BAR;
    if constexpr (Epi::AFTER_DRAIN) { E.fused(acc, cur, wr, wc, fr, fq, lds, wid, lane); S.done(cur); }
#undef PG8_SA
#undef PG8_SB
#undef PG8_STAGE
#undef PG8_LDA
#undef PG8_LDB
#undef PG8_MMA
#undef PG8_WAIT_V
#undef PG8_WAIT_L
#undef PG8_BAR
#undef PG8_SCHED
}
}
#define XB_TMO      128
#define XB_XCNT(j)  (256  + 64 * (j))
#define XB_XSUB(j)  (1280 + 64 * (j))
#define XB_XGEN(j)  (2304 + 64 * (j))
#define XB_TOP      3328
#define XB_TOPGEN   3392
#define XCD_BAR_WORDS 3456
#define XB_SPIN_CAP (1u << 18)

__device__ __forceinline__ unsigned xb_ld(unsigned* p)              { return __hip_atomic_load(p, __ATOMIC_RELAXED, __HIP_MEMORY_SCOPE_AGENT); }
__device__ __forceinline__ unsigned xb_add(unsigned* p, unsigned v) { return __hip_atomic_fetch_add(p, v, __ATOMIC_RELAXED, __HIP_MEMORY_SCOPE_AGENT); }
__device__ __forceinline__ unsigned xb_xcc_id() { return (unsigned)__builtin_amdgcn_s_getreg((3 << 11) | 20) & 0xFu; }
#define XB_SPIN(cond, bar) do { unsigned _sp = 0; while (cond) { __builtin_amdgcn_s_sleep(1); \
    if ((++_sp & 255u) == 0u) { if (xb_ld(&(bar)[XB_TMO])) break; if (_sp > XB_SPIN_CAP) { atomicAdd(&(bar)[XB_TMO], 1u); break; } } } } while (0)

struct XcdBarrier {
    unsigned* bar; unsigned x;
    volatile LAS unsigned* st;
};

__device__ __forceinline__ XcdBarrier xcd_barrier_post(unsigned* bar, volatile LAS unsigned* st) {
    XcdBarrier b; b.bar = bar; b.x = xb_xcc_id(); b.st = st;
    if (threadIdx.x == 0) (void)xb_add(&bar[XB_XCNT(b.x)], 1u);
    return b;
}
__device__ __forceinline__ void xcd_barrier_complete(unsigned* bar, unsigned x, unsigned& nloc, unsigned& nx) {
    const unsigned G = gridDim.x * gridDim.y * gridDim.z;
    unsigned sum, cnt, mine, sp = 0u;
    for (;;) {
        sum = 0u; cnt = 0u; mine = 0u;
#pragma unroll
        for (unsigned j = 0; j < 16; ++j) { const unsigned c = xb_ld(&bar[XB_XCNT(j)]); sum += c; cnt += (c > 0u) ? 1u : 0u; mine = (j == x) ? c : mine; }
        if (sum == G) break;
        __builtin_amdgcn_s_sleep(1);
        if ((++sp & 255u) == 0u) { if (xb_ld(&bar[XB_TMO])) break; if (sp > XB_SPIN_CAP) { atomicAdd(&bar[XB_TMO], 1u); break; } }
    }
    nloc = mine > 0u ? mine : 1u; nx = cnt > 0u ? cnt : 1u;
}

__device__ __forceinline__ void xcd_barrier(const XcdBarrier& b) {
    asm volatile("s_waitcnt vmcnt(0)" ::: "memory");
    __syncthreads();
    if (threadIdx.x == 0) {
        unsigned* bar = b.bar;
        __builtin_amdgcn_s_waitcnt(0);
        unsigned nloc = b.st[0], nx = b.st[1];
        if (nloc == 0u) { xcd_barrier_complete(bar, b.x, nloc, nx); b.st[0] = nloc; b.st[1] = nx; }
        const unsigned old = xb_add(&bar[XB_XSUB(b.x)], 1u);
        const unsigned gen = old / nloc;
        if (old + 1u == (gen + 1u) * nloc) {
            __builtin_amdgcn_fence(__ATOMIC_RELEASE, "agent");
            asm volatile("s_waitcnt vmcnt(0)" ::: "memory");
            const unsigned og = xb_add(&bar[XB_TOP], 1u);
            const unsigned tg = og / nx;
            if (og + 1u == (tg + 1u) * nx) xb_add(&bar[XB_TOPGEN], 1u);
            else XB_SPIN(xb_ld(&bar[XB_TOPGEN]) == tg, bar);
            __builtin_amdgcn_fence(__ATOMIC_ACQUIRE, "agent");
            xb_add(&bar[XB_XGEN(b.x)], 1u);
            asm volatile("s_waitcnt vmcnt(0)" ::: "memory");
        } else {
            XB_SPIN(xb_ld(&bar[XB_XGEN(b.x)]) == gen, bar);
            __builtin_amdgcn_fence(__ATOMIC_ACQUIRE, "agent");
            asm volatile("s_waitcnt vmcnt(0)" ::: "memory");
        }
    }
    __syncthreads();
}
namespace attn {
using namespace cfg;
constexpr int SLOTB = 8192, LDS_K = 0, LDS_V = 4 * SLOTB, LDS_WS = 8 * SLOTB, LDS_OST = LDS_WS + 8 * 64 * 4, LDS_BYTES = LDS_OST + 8 * 4096;
typedef __attribute__((address_space(3))) const char* lds_cptr;
typedef short v4i16_t __attribute__((ext_vector_type(4)));
__device__ __forceinline__ int crow(int r, int hi) { return (r & 3) + 8 * (r >> 2) + 4 * hi; }
__device__ __forceinline__ void glds16(const void* gsrc, unsigned lds_dst) { unsigned keep;
    asm volatile("s_mov_b32 %0, m0\n\ts_mov_b32 m0, %2\n\ts_nop 0\n\tglobal_load_lds_dwordx4 %1, off\n\ts_mov_b32 m0, %0" : "=&s"(keep) : "v"(gsrc), "s"(lds_dst) : "memory"); }
__device__ __forceinline__ s16x4 vtr(lds_cptr p) { return __builtin_bit_cast(s16x4, __builtin_amdgcn_ds_read_tr16_b64_v4i16((__attribute__((address_space(3))) v4i16_t*)p)); }
__device__ __forceinline__ float swapmax(float m) { auto rr = __builtin_amdgcn_permlane32_swap(__float_as_uint(m), __float_as_uint(m), false, false); return fmaxf(__uint_as_float(rr[0]), __uint_as_float(rr[1])); }
__device__ __forceinline__ float swapadd(float m) { auto rr = __builtin_amdgcn_permlane32_swap(__float_as_uint(m), __float_as_uint(m), false, false); return __uint_as_float(rr[0]) + __uint_as_float(rr[1]); }
#define ATT_WAIT_BAR() asm volatile("s_waitcnt vmcnt(0) lgkmcnt(0)\n\ts_barrier" ::: "memory")

__device__ __forceinline__ void attn_unit(int b, int hkv, int nb, const bf16* QA, const bf16* KVA, bf16* AO, const float* sinks, char* shm) {
    const int tid = threadIdx.x, lane = tid & 63, r32 = lane & 31, hi = lane >> 5; const int wid = __builtin_amdgcn_readfirstlane(tid >> 6);
    const int g = wid >> 1, ph = wid & 1, hq = hkv * 4 + g;
    const long rowbase = (long)b * SEQ; const unsigned lds0 = (unsigned)(uintptr_t)shm;
#pragma unroll
    for (int sl = 0; sl < 4; ++sl) {
        if (nb == 0 && sl < 2) { *(v4u*)(shm + LDS_K + sl * SLOTB + wid * 1024 + lane * 16) = (v4u){0u, 0u, 0u, 0u}; *(v4u*)(shm + LDS_V + sl * SLOTB + wid * 1024 + lane * 16) = (v4u){0u, 0u, 0u, 0u}; }
        else { const long k0 = rowbase + nb * 128 - 128 + 64 * sl;
            const bf16* ksrc = KVA + (k0 + lane) * 256 + hkv * 64 + wid * 8;
            const bf16* vsrc = KVA + (k0 + 16 * (wid & 3) + (lane >> 2)) * 256 + 128 + hkv * 64 + (wid >> 2) * 32 + (lane & 3) * 8;
            glds16(ksrc, (unsigned)__builtin_amdgcn_readfirstlane(lds0 + LDS_K + sl * SLOTB + wid * 1024)); glds16(vsrc, (unsigned)__builtin_amdgcn_readfirstlane(lds0 + LDS_V + sl * SLOTB + wid * 1024)); }
    }
    const bf16* Qw = QA + (rowbase + nb * 128 + 64 * ph) * 512 + hq * 64;
    bf16x8 qr[2][4];
#pragma unroll
    for (int qb = 0; qb < 2; ++qb)
#pragma unroll
        for (int d0 = 0; d0 < 4; ++d0) qr[qb][d0] = *reinterpret_cast<const bf16x8*>(Qw + (long)(32 * qb + r32) * 512 + d0 * 16 + hi * 8);
    const float slope2 = exp2f(-(float)(hq + 1)) * LOG2E, sink2 = sinks[hq] * LOG2E;
    float* wsf = (float*)(shm + LDS_WS) + wid * 64;
    const lds_cptr shm3 = (lds_cptr)shm; const lds_cptr vp0 = shm3 + LDS_V + ((lane >> 4) & 1) * 32 + (lane & 3) * 8 + (4 * hi + ((lane & 15) >> 2)) * 64;
    ATT_WAIT_BAR();
#pragma unroll
    for (int qb = 0; qb < 2; ++qb) {
        const int kb0 = 2 * ph + qb;
        f32x16 S[5];
#pragma unroll
        for (int j = 0; j < 5; ++j) { const int kb = kb0 + j; const char* kbase = shm + LDS_K + (kb >> 1) * SLOTB + hi * 1024 + ((kb & 1) * 32 + r32) * 16;
            S[j] = f32x16{};
#pragma unroll
            for (int d0 = 0; d0 < 4; ++d0) { const bf16x8 kf = *reinterpret_cast<const bf16x8*>(kbase + d0 * 2048); S[j] = __builtin_amdgcn_mfma_f32_32x32x16_bf16(kf, qr[qb][d0], S[j], 0, 0, 0); } }
        float mx = sink2;
#pragma unroll
        for (int j = 0; j < 5; ++j) { const bool dead = (nb == 0) && (kb0 + j < 4);
#pragma unroll
            for (int r = 0; r < 16; ++r) { const int cr = crow(r, hi); const int dist = 128 + r32 - 32 * j - cr; float s = S[j][r] - slope2 * (float)dist;
                bool ok = !dead; if (j == 0) ok = ok && (cr > r32); if (j == 4) ok = ok && (cr <= r32);
                s = ok ? s : -INFINITY; S[j][r] = s; mx = fmaxf(mx, s); } }
        mx = swapmax(mx);
        float l = 0.f;
#pragma unroll
        for (int j = 0; j < 5; ++j)
#pragma unroll
            for (int r = 0; r < 16; ++r) { const float p = __builtin_amdgcn_exp2f(S[j][r] - mx); S[j][r] = p; l += p; }
        l = swapadd(l) + __builtin_amdgcn_exp2f(sink2 - mx);
        f32x16 o[2]; o[0] = f32x16{}; o[1] = f32x16{};
#pragma unroll
        for (int j = 0; j < 5; ++j) { const int kb = kb0 + j; const lds_cptr vb = vp0 + (kb >> 1) * SLOTB;
#pragma unroll
            for (int s2 = 0; s2 < 2; ++s2) { const int ks = (kb & 1) * 2 + s2;
                v4u pw; pw.x = cvtpk(S[j][8 * s2 + 0], S[j][8 * s2 + 1]); pw.y = cvtpk(S[j][8 * s2 + 2], S[j][8 * s2 + 3]); pw.z = cvtpk(S[j][8 * s2 + 4], S[j][8 * s2 + 5]); pw.w = cvtpk(S[j][8 * s2 + 6], S[j][8 * s2 + 7]);
                const bf16x8 pa = __builtin_bit_cast(bf16x8, pw);
#pragma unroll
                for (int d0 = 0; d0 < 2; ++d0) { const s16x4 lo = vtr(vb + d0 * 4096 + ks * 1024), hh = vtr(vb + d0 * 4096 + ks * 1024 + 512);
                    const bf16x8 vf = (bf16x8){lo[0], lo[1], lo[2], lo[3], hh[0], hh[1], hh[2], hh[3]};
                    o[d0] = __builtin_amdgcn_mfma_f32_32x32x16_bf16(pa, vf, o[d0], 0, 0, 0); } } }
        if (hi == 0) wsf[32 + r32] = l; asm volatile("s_waitcnt lgkmcnt(0)" ::: "memory");
        float rli[16];
#pragma unroll
        for (int r = 0; r < 16; ++r) rli[r] = __builtin_amdgcn_rcpf(wsf[32 + crow(r, hi)]);
        bf16* Ow = AO + (rowbase + nb * 128 + 64 * ph + 32 * qb) * 512 + hq * 64;
        bf16* stg = (bf16*)(shm + LDS_OST) + wid * 2048;
#pragma unroll
        for (int r = 0; r < 16; ++r) { const int orow = crow(r, hi);
#pragma unroll
            for (int d0 = 0; d0 < 2; ++d0) stg[orow * 64 + d0 * 32 + r32] = (bf16)f2bf(o[d0][r] * rli[r]); }
        asm volatile("s_waitcnt lgkmcnt(0)" ::: "memory");
#pragma unroll
        for (int i = 0; i < 4; ++i) { const int row = i * 8 + (lane >> 3), ch = lane & 7; const v4u v = *(const v4u*)(stg + row * 64 + ch * 8); *(v4u*)(Ow + (long)row * 512 + ch * 8) = v; }
        asm volatile("s_waitcnt lgkmcnt(0)" ::: "memory");
    }
    asm volatile("s_waitcnt lgkmcnt(0)\n\ts_barrier" ::: "memory");
}
__device__ __forceinline__ void attn_phase(char* lds, int vcu, int G, const bf16* QA, const bf16* KVA, bf16* AO, const float* sinks) {
    for (int u = vcu; u < BATCH * 2 * 32; u += G) { const int b = u >> 6, hkv = (u >> 5) & 1, nb = u & 31; attn_unit(b, hkv, nb, QA, KVA, AO, sinks, lds); }
}
#undef ATT_WAIT_BAR
}
namespace mk {
using namespace cfg;
constexpr int NWAVES = 8, NTHREADS = 512;
constexpr int RING_OFF = 0, RING_BYTES = 131072;
constexpr int LDSCTL_OFF = RING_BYTES, MISC_OFF = LDSCTL_OFF + 320;
constexpr int LDS_BYTES = 147456;
constexpr int CW_TMO = 0, CW_CODE = 1, CW_BAR = 4096, N_BAR_REGIONS = 8;
static_assert((CW_BAR + N_BAR_REGIONS * XCD_BAR_WORDS) * 4 <= (int)MiB, "CTL words inside the memset region");
constexpr size_t WS_SS1X = 4 * MiB;
enum Phase { P_PRO = 0, P_G1, P_MIX_A, P_SCAN, P_MIX_C, P_G2, P_G3, P_G4, P_G5, P_FIN, N_PHASES };

struct Args { const float* in[17]; float* out; unsigned char* ws; int ph_lo, ph_hi, li, pad; };

struct Frame {
    LAS unsigned char* lds; volatile LAS unsigned* MISC; gu32* ctl;
    int tid, lane, wave, vcu, G;
};

__device__ __forceinline__ float wave_sum(float v) {
#pragma unroll
    for (int o = 1; o < 64; o <<= 1) v += __shfl_xor(v, o);
    return v;
}

__device__ __forceinline__ void p0_transpose_item(const float* W, int ldw, int src_c0, const float* scale, bf16* WT, int K, int dst_r0, int kb, LAS float* scr, int lane) {
    const int k0 = 64 * kb;
#pragma unroll 8
    for (int i = 0; i < 32; ++i) { const int kk = 2 * i + (lane >> 5); float v = W[(size_t)(k0 + kk) * ldw + src_c0 + (lane & 31)]; if (scale) v *= scale[k0 + kk]; scr[kk * 33 + (lane & 31)] = v; }
    LDS_WAIT(); asm volatile("" ::: "memory");
    const int c = lane & 7;
#pragma unroll
    for (int j = 0; j < 4; ++j) { const int n = (lane >> 3) + 8 * j; const LAS float* s = scr + (8 * c) * 33 + n;
        v4u o; o.x = pk2(s[0 * 33], s[1 * 33]); o.y = pk2(s[2 * 33], s[3 * 33]); o.z = pk2(s[4 * 33], s[5 * 33]); o.w = pk2(s[6 * 33], s[7 * 33]);
        *(GAS v4u*)(WT + (size_t)(dst_r0 + n) * K + k0 + 8 * c) = o; }
    LDS_WAIT(); asm volatile("" ::: "memory");
}
__device__ __forceinline__ void p0_prologue(Frame& F, const Args& a) {
    LAS float* scr = (LAS float*)(F.lds + RING_OFF + F.wave * 16384);
    const int gw = F.vcu * NWAVES + F.wave, NGW = F.G * NWAVES;
    unsigned char* ws = a.ws;
    constexpr int I0 = 16 * 72, I1 = 16 * 64, I2 = 8 * 32, I3 = 8 * 32, I4 = 16 * 32, I5 = 16 * 88, I6 = 16 * 88, I7 = 44 * 32;
    constexpr int NITEMS = I0 + I1 + I2 + I3 + I4 + I5 + I6 + I7;
    for (int it = gw; it < NITEMS; it += NGW) {
        int r = it;
        if (r < I0) { const int kb = r / 72, nb = r % 72; p0_transpose_item(a.in[2], INW, 32 * nb, nullptr, (bf16*)(ws + WS_WIN), 1024, 32 * nb, kb, scr, F.lane); continue; } r -= I0;
        if (r < I1) { const int kb = r / 64, nb = r % 64; p0_transpose_item(a.in[2], INW, C_GA + 32 * nb, nullptr, (bf16*)(ws + WS_WIN), 1024, 2304 + 32 * nb, kb, scr, F.lane); continue; } r -= I1;
        if (r < I2) { const int kb = r / 32, nb = r % 32; p0_transpose_item(a.in[9], 1024, 32 * nb, nullptr, (bf16*)(ws + WS_WA), 512, 32 * nb, kb, scr, F.lane); continue; } r -= I2;
        if (r < I3) { const int kb = r / 32, nb = r % 32; p0_transpose_item(a.in[10], 1024, 32 * nb, nullptr, (bf16*)(ws + WS_WM), 512, 32 * nb, kb, scr, F.lane); continue; } r -= I3;
        if (r < I4) { const int kb = r / 32, nb = r % 32; p0_transpose_item(a.in[11], 1024, 32 * nb, nullptr, (bf16*)(ws + WS_WO), 1024, 32 * nb, kb, scr, F.lane); continue; } r -= I4;
        if (r < I5) { const int kb = r / 88, nb = r % 88, n0 = 32 * nb; p0_transpose_item(a.in[13], FF, n0, a.in[12], (bf16*)(ws + WS_WGU), 1024, 256 * (n0 >> 7) + (n0 & 127), kb, scr, F.lane); continue; } r -= I5;
        if (r < I6) { const int kb = r / 88, nb = r % 88, n0 = 32 * nb; p0_transpose_item(a.in[14], FF, n0, a.in[12], (bf16*)(ws + WS_WGU), 1024, 256 * (n0 >> 7) + 128 + (n0 & 127), kb, scr, F.lane); continue; } r -= I6;
        { const int kb = r / 32, nb = r % 32; p0_transpose_item(a.in[15], 1024, 32 * nb, nullptr, (bf16*)(ws + WS_WD), FF, 32 * nb, kb, scr, F.lane); }
    }
    const float* x = a.in[0]; const float* g1 = a.in[1]; const float* w_in = a.in[2];
    f32x4 gwa[4][4], gwb[4][4], g1v[4];
#pragma unroll
    for (int j = 0; j < 4; ++j) { g1v[j] = *(const f32x4*)(g1 + 256 * j + 4 * F.lane);
#pragma unroll
        for (int q = 0; q < 4; ++q) { const float* p = w_in + (size_t)(256 * j + 4 * F.lane + q) * INW + C_MI; gwa[j][q] = *(const f32x4*)p; gwb[j][q] = *(const f32x4*)(p + 4); } }
    bf16* XN = (bf16*)(ws + WS_XN); float* GATES = (float*)(ws + WS_GATES);
    for (int m = gw; m < M; m += NGW) {
        const GAS f32x4* xr = (const GAS f32x4*)(x + (size_t)m * D) + F.lane;
        f32x4 v[4]; float s = 0.f;
#pragma unroll
        for (int j = 0; j < 4; ++j) { v[j] = xr[64 * j]; s += (v[j].x * v[j].x + v[j].y * v[j].y) + (v[j].z * v[j].z + v[j].w * v[j].w); }
        const float r = rsqrtf(wave_sum(s) * (1.f / D) + EPS);
        GAS unsigned long long* o8 = (GAS unsigned long long*)(XN + (size_t)m * D) + F.lane;
        f32x4 ga = {0.f, 0.f, 0.f, 0.f}, gb = {0.f, 0.f, 0.f, 0.f};
#pragma unroll
        for (int j = 0; j < 4; ++j) { const f32x4 u = v[j] * r * g1v[j];
            o8[64 * j] = (unsigned long long)pk2(u.x, u.y) | ((unsigned long long)pk2(u.z, u.w) << 32);
            ga += gwa[j][0] * u.x + gwa[j][1] * u.y + gwa[j][2] * u.z + gwa[j][3] * u.w;
            gb += gwb[j][0] * u.x + gwb[j][1] * u.y + gwb[j][2] * u.z + gwb[j][3] * u.w; }
#pragma unroll
        for (int o = 1; o < 64; o <<= 1) {
#pragma unroll
            for (int e = 0; e < 4; ++e) { ga[e] += __shfl_xor(ga[e], o); gb[e] += __shfl_xor(gb[e], o); } }
        if (F.lane == 0) { *(GAS f32x4*)(GATES + (size_t)m * 8) = ga; *(GAS f32x4*)(GATES + (size_t)m * 8 + 4) = gb; }
    }
}

typedef pg8::f32x4 af4;
__device__ __forceinline__ v4u pack8(af4 v0, af4 v1) { v4u w; w.x = cvtpk(v0[0], v0[1]); w.y = cvtpk(v0[2], v0[3]); w.z = cvtpk(v1[0], v1[1]); w.w = cvtpk(v1[2], v1[3]); return w; }
__device__ __forceinline__ void unpack8(v4u w, af4& v0, af4& v1) {
    v0[0] = __builtin_bit_cast(float, w.x << 16); v0[1] = __builtin_bit_cast(float, w.x & 0xffff0000u); v0[2] = __builtin_bit_cast(float, w.y << 16); v0[3] = __builtin_bit_cast(float, w.y & 0xffff0000u);
    v1[0] = __builtin_bit_cast(float, w.z << 16); v1[1] = __builtin_bit_cast(float, w.z & 0xffff0000u); v1[2] = __builtin_bit_cast(float, w.w << 16); v1[3] = __builtin_bit_cast(float, w.w & 0xffff0000u); }
__device__ __forceinline__ af4 sig4(af4 v) { af4 o; o[0] = fast_sigmoid(v[0]); o[1] = fast_sigmoid(v[1]); o[2] = fast_sigmoid(v[2]); o[3] = fast_sigmoid(v[3]); return o; }

struct EpiG1 {
    static constexpr bool PERM = true, AFTER_DRAIN = false; unsigned char* ws;
    __device__ __forceinline__ void operator()(const af4 (&acc)[2][2][4][2], const pg8::Unit& u, int wr, int wc, int fr, int fq) const {
        const int pn = u.pn; size_t off; int ld, ct, act;
        if (pn < 2) { off = WS_QA; ld = 512; ct = pn; act = 1; } else if (pn == 2) { off = WS_KVA; ld = 256; ct = 0; act = 0; } else if (pn < 5) { off = WS_MQK; ld = 512; ct = pn - 3; act = 0; }
        else if (pn < 7) { off = WS_MV; ld = 512; ct = pn - 5; act = 0; } else if (pn < 9) { off = WS_MO; ld = 512; ct = pn - 7; act = 2; } else if (pn < 13) { off = WS_GA; ld = 1024; ct = pn - 9; act = 2; } else { off = WS_GM; ld = 1024; ct = pn - 13; act = 2; }
        bf16* base = (bf16*)(ws + off) + (size_t)(u.pm * 256 + wr * 64 + fr) * ld + ct * 256 + wc * 32 + 8 * fq;
#pragma unroll
        for (int ai = 0; ai < 2; ++ai)
#pragma unroll
            for (int m = 0; m < 4; ++m) { bf16* rowp = base + (size_t)(ai * 128 + m * 16) * ld;
#pragma unroll
                for (int bj = 0; bj < 2; ++bj) { af4 v0 = acc[ai][bj][m][0], v1 = acc[ai][bj][m][1];
                    if (act == 1) { v0 = v0 * QSCALE; v1 = v1 * QSCALE; } else if (act == 2) { v0 = sig4(v0); v1 = sig4(v1); }
                    *(v4u*)(rowp + bj * 128) = pack8(v0, v1); } }
    }
};
struct DualOrder {
    pg8::StaticOrder so;
    __device__ __forceinline__ bool next(int i, pg8::Unit& u) const { if (!so.next(i >> 1, u)) return false; u.sel = i & 1; return true; }
    __device__ __forceinline__ void a_ready(const pg8::Unit&) const {}
    __device__ __forceinline__ void done(const pg8::Unit&) const {}
};
struct EpiG2 {
    static constexpr bool PERM = true, AFTER_DRAIN = false; const bf16* GA; const bf16* GM; bf16* TMP; bf16* MG;
    __device__ __forceinline__ void operator()(const af4 (&acc)[2][2][4][2], const pg8::Unit& u, int wr, int wc, int fr, int fq) const {
        const size_t o0 = (size_t)(u.pm * 256 + wr * 64 + fr) * 1024 + u.pn * 256 + wc * 32 + 8 * fq;
#pragma unroll
        for (int ai = 0; ai < 2; ++ai)
#pragma unroll
            for (int m = 0; m < 4; ++m)
#pragma unroll
                for (int bj = 0; bj < 2; ++bj) { const size_t o = o0 + (size_t)(ai * 128 + m * 16) * 1024 + bj * 128; af4 g0, g1;
                    if (u.sel == 0) { unpack8(*(const v4u*)(GA + o), g0, g1); *(v4u*)(TMP + o) = pack8(acc[ai][bj][m][0] * g0, acc[ai][bj][m][1] * g1); }
                    else { af4 t0, t1; unpack8(*(const v4u*)(GM + o), g0, g1); unpack8(*(const v4u*)(TMP + o), t0, t1); *(v4u*)(MG + o) = pack8(acc[ai][bj][m][0] * g0 + t0, acc[ai][bj][m][1] * g1 + t1); } }
    }
};
struct EpiG3 {
    static constexpr bool PERM = true, AFTER_DRAIN = false; const float* x; float* out; bf16* X1B; float* SS;
    __device__ __forceinline__ void operator()(const af4 (&acc)[2][2][4][2], const pg8::Unit& u, int wr, int wc, int fr, int fq) const {
        const int row0 = u.pm * 256 + wr * 64 + fr; const size_t o0 = (size_t)row0 * 1024 + u.pn * 256 + wc * 32 + 8 * fq;
#pragma unroll
        for (int ai = 0; ai < 2; ++ai)
#pragma unroll
            for (int m = 0; m < 4; ++m) { float ss = 0.f;
#pragma unroll
                for (int bj = 0; bj < 2; ++bj) { const size_t o = o0 + (size_t)(ai * 128 + m * 16) * 1024 + bj * 128;
                    const af4 a0 = *(const af4*)(x + o) + acc[ai][bj][m][0], a1 = *(const af4*)(x + o + 4) + acc[ai][bj][m][1];
                    *(af4*)(out + o) = a0; *(af4*)(out + o + 4) = a1; *(v4u*)(X1B + o) = pack8(a0, a1);
                    ss += (a0[0] * a0[0] + a0[1] * a0[1]) + (a0[2] * a0[2] + a0[3] * a0[3]) + (a1[0] * a1[0] + a1[1] * a1[1]) + (a1[2] * a1[2] + a1[3] * a1[3]); }
                ss += __shfl_xor(ss, 16); ss += __shfl_xor(ss, 32);
                if (fq == 0) SS[(size_t)(row0 + ai * 128 + m * 16) * 16 + u.pn * 4 + wc] = ss; }
    }
};
struct EpiG4 {
    static constexpr bool PERM = true, AFTER_DRAIN = false; const float* SS; bf16* HB;
    __device__ __forceinline__ void operator()(const af4 (&acc)[2][2][4][2], const pg8::Unit& u, int wr, int wc, int fr, int fq) const {
        const int row0 = u.pm * 256 + wr * 64 + fr;
#pragma unroll
        for (int ai = 0; ai < 2; ++ai)
#pragma unroll
            for (int m = 0; m < 4; ++m) { const int row = row0 + ai * 128 + m * 16;
                const af4 p = *(const af4*)(SS + (size_t)row * 16 + 4 * fq); float s = (p[0] + p[1]) + (p[2] + p[3]); s += __shfl_xor(s, 16); s += __shfl_xor(s, 32);
                const float r = rsqrtf(s * (1.f / D) + EPS); af4 h0, h1;
#pragma unroll
                for (int e = 0; e < 4; ++e) { const float g0 = acc[ai][0][m][0][e] * r, g1 = acc[ai][0][m][1][e] * r; h0[e] = g0 * fast_sigmoid(g0) * (acc[ai][1][m][0][e] * r); h1[e] = g1 * fast_sigmoid(g1) * (acc[ai][1][m][1][e] * r); }
                *(v4u*)(HB + (size_t)row * FF + u.pn * 128 + wc * 32 + 8 * fq) = pack8(h0, h1); }
    }
};
struct EpiG5 {
    static constexpr bool PERM = true, AFTER_DRAIN = false; float* out;
    __device__ __forceinline__ void operator()(const af4 (&acc)[2][2][4][2], const pg8::Unit& u, int wr, int wc, int fr, int fq) const {
        const size_t o0 = (size_t)(u.pm * 256 + wr * 64 + fr) * 1024 + u.pn * 256 + wc * 32 + 8 * fq;
#pragma unroll
        for (int ai = 0; ai < 2; ++ai)
#pragma unroll
            for (int m = 0; m < 4; ++m)
#pragma unroll
                for (int bj = 0; bj < 2; ++bj) { const size_t o = o0 + (size_t)(ai * 128 + m * 16) * 1024 + bj * 128;
                    const af4 a0 = *(const af4*)(out + o) + acc[ai][bj][m][0], a1 = *(const af4*)(out + o + 4) + acc[ai][bj][m][1]; *(af4*)(out + o) = a0; *(af4*)(out + o + 4) = a1; }
    }
};
__device__ __forceinline__ void p_final_norm(Frame& F, float* out, const float* gF) {
    const int gw = F.vcu * NWAVES + F.wave, NGW = F.G * NWAVES;
    const int lane = (int)__builtin_amdgcn_mbcnt_hi(~0u, __builtin_amdgcn_mbcnt_lo(~0u, 0u));
    f32x4 gv[4];
#pragma unroll
    for (int j = 0; j < 4; ++j) gv[j] = *(const f32x4*)(gF + 256 * j + 4 * lane);
    for (int m = gw; m < M; m += NGW) { GAS f32x4* xr = (GAS f32x4*)(out + (size_t)m * D) + lane; f32x4 v[4]; float s = 0.f;
#pragma unroll
        for (int j = 0; j < 4; ++j) { v[j] = xr[64 * j]; s += (v[j].x * v[j].x + v[j].y * v[j].y) + (v[j].z * v[j].z + v[j].w * v[j].w); }
        const float r = rsqrtf(wave_sum(s) * (1.f / D) + EPS);
#pragma unroll
        for (int j = 0; j < 4; ++j) xr[64 * j] = v[j] * r * gv[j]; }
}

__global__ void __launch_bounds__(NTHREADS, 2) mega(Args args) {
    extern __shared__ __attribute__((aligned(16))) unsigned char lds[];
    Frame F;
    F.lds = (LAS unsigned char*)lds; F.MISC = (volatile LAS unsigned*)(F.lds + MISC_OFF);
    F.tid = threadIdx.x; F.lane = F.tid & 63; F.wave = __builtin_amdgcn_readfirstlane(F.tid >> 6);
    F.G = gridDim.x; { const int bx = blockIdx.x; F.vcu = (F.G % 8 == 0) ? (bx % 8) * (F.G / 8) + bx / 8 : bx; }
    unsigned char* ws = args.ws; F.ctl = (gu32*)(ws + WS_CTL);
    for (int u = F.tid; u < (LDS_BYTES - LDSCTL_OFF) / 4; u += NTHREADS) ((LAS unsigned*)(F.lds + LDSCTL_OFF))[u] = 0u;
    __syncthreads();
    const int lo = args.ph_lo, hi = args.ph_hi;
    XcdBarrier bar; bar.bar = (unsigned*)(F.ctl + CW_BAR) + args.li * XCD_BAR_WORDS; bar.x = 0; bar.st = nullptr;
    if (hi - lo > 1) bar = xcd_barrier_post((unsigned*)(F.ctl + CW_BAR) + args.li * XCD_BAR_WORDS, F.MISC + 8);
#define IN(k) (lo <= (k) && (k) < hi)
#define SEAM(k) do { if (IN(k) && IN((k) + 1)) xcd_barrier(bar); } while (0)
    float* out = args.out;
    if (IN(P_PRO)) { p0_prologue(F, args); SEAM(P_PRO); }
    if (IN(P_G1)) {
        pg8::Gemm g{(const bf16*)(ws + WS_XN), (const bf16*)(ws + WS_WIN), M, 4352, 1024, nullptr, nullptr}; pg8::StaticOrder S; S.init(M, 4352, F.G, (int)blockIdx.x);
        EpiG1 E{ws}; pg8::gemm_phase<EpiG1, pg8::StaticOrder, true, true>(F.lds + RING_OFF, g, S, E);
        SEAM(P_G1);
    }
    if (IN(P_MIX_A)) {
        attn::attn_phase((char*)lds + RING_OFF, F.vcu, F.G, (const bf16*)(ws + WS_QA), (const bf16*)(ws + WS_KVA), (bf16*)(ws + WS_AO), args.in[8]);
        SEAM(P_MIX_A);
    }
    if (IN(P_SCAN)) { SEAM(P_SCAN); }
    if (IN(P_MIX_C)) { SEAM(P_MIX_C); }
    if (IN(P_G2)) {
        pg8::Gemm g{(const bf16*)(ws + WS_AO), (const bf16*)(ws + WS_WA), M, 1024, 512, (const bf16*)(ws + WS_HN), (const bf16*)(ws + WS_WM)}; DualOrder S; S.so.init(M, 1024, F.G, (int)blockIdx.x);
        EpiG2 E{(const bf16*)(ws + WS_GA), (const bf16*)(ws + WS_GM), (bf16*)(ws + WS_TMP), (bf16*)(ws + WS_MG)}; pg8::gemm_phase<EpiG2, DualOrder, true, true>(F.lds + RING_OFF, g, S, E);
        SEAM(P_G2);
    }
    if (IN(P_G3)) {
        pg8::Gemm g{(const bf16*)(ws + WS_MG), (const bf16*)(ws + WS_WO), M, 1024, 1024, nullptr, nullptr}; pg8::StaticOrder S; S.init(M, 1024, F.G, (int)blockIdx.x);
        EpiG3 E{args.in[0], out, (bf16*)(ws + WS_X1B), (float*)(ws + WS_SS1X)}; pg8::gemm_phase<EpiG3, pg8::StaticOrder, true, true>(F.lds + RING_OFF, g, S, E);
        SEAM(P_G3);
    }
    if (IN(P_G4)) {
        pg8::Gemm g{(const bf16*)(ws + WS_X1B), (const bf16*)(ws + WS_WGU), M, 2 * FF, 1024, nullptr, nullptr}; pg8::StaticOrder S; S.init(M, 2 * FF, F.G, (int)blockIdx.x);
        EpiG4 E{(const float*)(ws + WS_SS1X), (bf16*)(ws + WS_HB)}; pg8::gemm_phase<EpiG4, pg8::StaticOrder, true, true>(F.lds + RING_OFF, g, S, E);
        SEAM(P_G4);
    }
    if (IN(P_G5)) {
        pg8::Gemm g{(const bf16*)(ws + WS_HB), (const bf16*)(ws + WS_WD), M, 1024, FF, nullptr, nullptr}; pg8::StaticOrder S; S.init(M, 1024, F.G, (int)blockIdx.x);
        EpiG5 E{out}; pg8::gemm_phase<EpiG5, pg8::StaticOrder, true, true>(F.lds + RING_OFF, g, S, E);
        SEAM(P_G5);
    }
    if (IN(P_FIN)) { p_final_norm(F, out, args.in[16]); }
#undef IN
#undef SEAM
}
}
static void launch_mega(const mk::Args& a0, int lo, int hi, int li, int grid, hipStream_t stream) {
    mk::Args a = a0; a.ph_lo = lo; a.ph_hi = hi; a.li = li;
    hipLaunchKernelGGL(mk::mega, dim3(grid), dim3(mk::NTHREADS), mk::LDS_BYTES, stream, a);
}
extern "C" void kernel_launch(void* const* d_in, const int* in_sizes, int n_in, void* d_out, int out_size, void* d_ws, size_t ws_size, hipStream_t stream) {
    using namespace cfg; using namespace naive;
    static int grid = 0;
    constexpr int LDS_ATT = 2 * 256 * 66 * 2, LDS_MA = (8192 + 8192 + 128 + 8) * 4, LDS_MC = (8192 + 8192 + 8192 + 128 + 128 + 64 + 128 * 65) * 4;
    if (grid == 0) {
        if (n_in != 17 || in_sizes[0] != M * D || out_size != M * D || ws_size < WS_END) { fprintf(stderr, "kernel_launch: unexpected shapes n_in %d in0 %d out %d ws %zu\n", n_in, in_sizes[0], out_size, ws_size); grid = -1; return; }
        int dev = 0, cus = 0;
        if (hipGetDevice(&dev) != hipSuccess || hipDeviceGetAttribute(&cus, hipDeviceAttributeMultiprocessorCount, dev) != hipSuccess) { grid = -1; return; }
        (void)hipFuncSetAttribute((const void*)k_attn, hipFuncAttributeMaxDynamicSharedMemorySize, LDS_ATT);
        (void)hipFuncSetAttribute((const void*)k_mlstm_a, hipFuncAttributeMaxDynamicSharedMemorySize, LDS_MA);
        (void)hipFuncSetAttribute((const void*)k_mlstm_c, hipFuncAttributeMaxDynamicSharedMemorySize, LDS_MC);
        if (hipFuncSetAttribute((const void*)mk::mega, hipFuncAttributeMaxDynamicSharedMemorySize, mk::LDS_BYTES) != hipSuccess) { fprintf(stderr, "kernel_launch: hipFuncSetAttribute failed\n"); grid = -1; return; }
        grid = cus;
    }
    if (grid < 0) return;
    const float* cw = (const float*)d_in[3]; const float* cb = (const float*)d_in[4];
    const float* ib = (const float*)d_in[5]; const float* fb = (const float*)d_in[6]; const float* gmn = (const float*)d_in[7]; const float* sinks = (const float*)d_in[8];
    unsigned char* ws = (unsigned char*)d_ws;
    float* GATES = (float*)(ws + WS_GATES); float* MSM = (float*)(ws + WS_MSM);
    bf16 *QA = (bf16*)(ws + WS_QA), *KVA = (bf16*)(ws + WS_KVA), *MQK = (bf16*)(ws + WS_MQK), *MV = (bf16*)(ws + WS_MV), *MO = (bf16*)(ws + WS_MO);
    bf16 *AO = (bf16*)(ws + WS_AO), *HN = (bf16*)(ws + WS_HN);
    float *CLOC = (float*)(ws + WS_CLOC), *CST = (float*)(ws + WS_CST);
    (void)hipMemsetAsync(ws + WS_CTL, 0, MiB, stream);
    mk::Args a{}; for (int i = 0; i < 17; ++i) a.in[i] = (const float*)d_in[i]; a.out = (float*)d_out; a.ws = ws;
    launch_mega(a, mk::P_PRO, mk::P_MIX_A + 1, 0, grid, stream);
    k_mlstm_a<<<dim3(32, 4, 8), 256, LDS_MA, stream>>>(MQK, MV, GATES, cw, cb, ib, fb, CLOC, MSM);
    k_mlstm_b<<<dim3((8192 + 64 + 255) / 256, 32), 256, 0, stream>>>(CLOC, CST, MSM);
    k_mlstm_c<<<dim3(32, 4, 8), 128, LDS_MC, stream>>>(MQK, MV, MO, GATES, cw, cb, ib, fb, gmn, CST, MSM, HN);
    launch_mega(a, mk::P_G2, mk::N_PHASES, 1, grid, stream);
}
```

```cpp
#include <hip/hip_runtime.h>
#include <cstdio>
#include <cstdint>

namespace cfg {
constexpr int BATCH = 8, SEQ = 4096, D = 1024, M = BATCH * SEQ, INW = 4360, FF = 2816;
constexpr int C_AQ = 0, C_AK = 512, C_AV = 640, C_MQK = 768, C_MV = 1280, C_MO = 1792, C_MI = 2304, C_MF = 2308, C_GA = 2312, C_GM = 3336;
constexpr float EPS = 1e-6f, LOG2E = 1.4426950408889634f, QSCALE = 0.125f * LOG2E;
constexpr size_t MiB = 1u << 20;
constexpr size_t WS_CTL = 0;
constexpr size_t WS_GATES = 1 * MiB;
constexpr size_t WS_SS1 = 2 * MiB;
constexpr size_t WS_MSM = 3 * MiB;
constexpr size_t WS_WIN = 8 * MiB;
constexpr size_t WS_WA = 17 * MiB, WS_WM = 18 * MiB, WS_WO = 19 * MiB, WS_WGU = 21 * MiB, WS_WD = 32 * MiB;
constexpr size_t WS_XN = 40 * MiB;
constexpr size_t WS_QA = 104 * MiB;
constexpr size_t WS_KVA = 136 * MiB;
constexpr size_t WS_MQK = 152 * MiB;
constexpr size_t WS_MV = 184 * MiB;
constexpr size_t WS_MO = 216 * MiB;
constexpr size_t WS_GA = 248 * MiB;
constexpr size_t WS_GM = 312 * MiB;
constexpr size_t WS_AO = 376 * MiB;
constexpr size_t WS_HN = 408 * MiB;
constexpr size_t WS_CLOC = 440 * MiB;
constexpr size_t WS_CST = 472 * MiB;
constexpr size_t WS_END = 504 * MiB;
constexpr size_t WS_MG = WS_XN;
constexpr size_t WS_TMP = 104 * MiB;
constexpr size_t WS_X1B = 168 * MiB;
constexpr size_t WS_HB = 232 * MiB;
}

typedef unsigned short bf16;
__device__ __forceinline__ unsigned f2bf(float f) { unsigned u = __builtin_bit_cast(unsigned, f); return (u + 0x7fffu + ((u >> 16) & 1u)) >> 16; }
__device__ __forceinline__ float bf2f(bf16 h) { return __builtin_bit_cast(float, (unsigned)h << 16); }
__device__ __forceinline__ float sigmoidf_(float x) { return 1.f / (1.f + __expf(-x)); }
__device__ __forceinline__ float siluf_(float x) { return x / (1.f + __expf(-x)); }
__device__ __forceinline__ float logsigmoidf_(float z) { return fminf(z, 0.f) - log1pf(__expf(-fabsf(z))); }


#define GAS __attribute__((address_space(1)))
#define LAS __attribute__((address_space(3)))
typedef unsigned v4u __attribute__((ext_vector_type(4)));
typedef unsigned v2u __attribute__((ext_vector_type(2)));
typedef float f32x4 __attribute__((ext_vector_type(4)));
typedef float f32x2 __attribute__((ext_vector_type(2)));
typedef float f32x16 __attribute__((ext_vector_type(16)));
typedef short bf16x8 __attribute__((ext_vector_type(8)));
typedef short s16x4 __attribute__((ext_vector_type(4)));
typedef GAS unsigned gu32;
typedef GAS unsigned long long gu64;
#define RLX_AGENT __ATOMIC_RELAXED, __HIP_MEMORY_SCOPE_AGENT
#define LDS_WAIT() asm volatile("s_waitcnt lgkmcnt(0)" ::: "memory")
#define VM_WAIT() asm volatile("s_waitcnt vmcnt(0)" ::: "memory")
__device__ __forceinline__ unsigned long long rt() { return __builtin_amdgcn_s_memrealtime(); }
__device__ __forceinline__ unsigned pk2(float lo, float hi) { return f2bf(lo) | (f2bf(hi) << 16); }
typedef __bf16 bf16x2_t __attribute__((ext_vector_type(2)));
__device__ __forceinline__ unsigned cvtpk(float lo, float hi) { f32x2 v = {lo, hi}; bf16x2_t b = __builtin_convertvector(v, bf16x2_t); return __builtin_bit_cast(unsigned, b); }
__device__ __forceinline__ float fast_sigmoid(float x) { return __builtin_amdgcn_rcpf(1.f + __builtin_amdgcn_exp2f(-cfg::LOG2E * x)); }
namespace pg8 {
#define PG8_LAS __attribute__((address_space(3)))
typedef unsigned short bf16_t;
typedef short bf16x8 __attribute__((ext_vector_type(8)));
typedef float f32x4 __attribute__((ext_vector_type(4)));
typedef unsigned u32x4 __attribute__((ext_vector_type(4)));
constexpr int BM = 256, BK = 64, HALF = 128, HTB = HALF * BK * 2  , STAGE_BYTES = 8 * HTB, NXCD = 8, WGM = 8;

__host__ __device__ __forceinline__ int lds_byte(int r, int c) { const int st = (r >> 4) * 2 + (c >> 5), rr = r & 15, cc = c & 31, ob = rr * 64 + cc * 2; return st * 1024 + (ob ^ (((ob >> 9) & 1) << 5)); }
__host__ __device__ __forceinline__ void stage_rc(int b, int& R, int& C) { const int st = b / 1024, sb = b % 1024, swz = sb ^ (((sb >> 9) & 1) << 5); R = (st >> 1) * 16 + swz / 64; C = (st & 1) * 32 + (swz % 64) / 2; }
__host__ __device__ __forceinline__ int perm32(int rho) { const int n = rho >> 4, i = rho & 15; return 8 * (i >> 2) + 4 * n + (i & 3); }

struct Unit { int pm, pn, sel; };
struct Gemm { const bf16_t* A; const bf16_t* Bt; int M, N, K; const bf16_t* A2; const bf16_t* Bt2; };

struct StaticOrder {
    int nM, nN, nwg, G, c;
    __host__ __device__ void init(int M, int N, int G_, int c_) { nM = M / BM; nN = N / BM; nwg = nM * nN; G = G_; c = c_; }
    __host__ __device__ bool next(int i, Unit& u) const {
        const long L = (long)i * G + c; if (L >= nwg) return false;
        int wgid = (int)L; { const int q = nwg / NXCD, r = nwg % NXCD, xcd = wgid % NXCD, off = wgid / NXCD; wgid = (xcd < r ? xcd * (q + 1) : r * (q + 1) + (xcd - r) * q) + off; }
        const int nig = WGM * nN, gid = wgid / nig, fm = gid * WGM, gsz = (nM - fm) < WGM ? (nM - fm) : WGM;
        u.pm = fm + ((wgid % nig) % gsz); u.pn = (wgid % nig) / gsz; u.sel = 0; return true;
    }
    __device__ __forceinline__ void a_ready(const Unit&) const {}
    __device__ __forceinline__ void done(const Unit&) const {}
};

__device__ __forceinline__ unsigned cvt_pk_bf16(float lo, float hi) { unsigned r; asm volatile("v_cvt_pk_bf16_f32 %0, %1, %2" : "=v"(r) : "v"(lo), "v"(hi)); return r; }
template <class Epi, class Sched, bool ALIGN_EPI = false, bool SP2 = false>
__device__ __forceinline__ void gemm_phase(PG8_LAS unsigned char* lds, const Gemm g, const Sched& S, const Epi& E) {
    const int tid = threadIdx.x, wid = __builtin_amdgcn_readfirstlane(tid >> 6), lane = tid & 63, wr = wid >> 2, wc = wid & 3, fr = lane & 15, fq = lane >> 4;
    const int K = g.K, nt = K / BK;
    unsigned voffA[2], voffB[2];
#pragma unroll
    for (int i = 0; i < 2; ++i) { int R, C; stage_rc(tid * 16 + i * 8192, R, C); const int Rb = Epi::PERM ? ((R & ~31) + perm32(R & 31)) : R;
        voffA[i] = (unsigned)(R * K + C) * 2u; voffB[i] = (unsigned)(Rb * K + C) * 2u; }
    const size_t kstep = (size_t)(BK * 2);
    const size_t hstep = (size_t)HALF * K * 2;
    const size_t tstep = 2 * hstep;
    const unsigned ldsw = (unsigned)wid * 1024u;
    const int aoff = lds_byte(wr * 64 + fr, fq * 8), boff = lds_byte(wc * 32 + fr, fq * 8);
#define PG8_SA(b, h) (((b) * 2 + (h)) * HTB)
#define PG8_SB(b, h) ((4 + (b) * 2 + (h)) * HTB)
#define PG8_STAGE(bufoff, gbase, voff) do { _Pragma("unroll") for (int _i = 0; _i < 2; ++_i) \
        __builtin_amdgcn_global_load_lds((const unsigned*)((const char*)(gbase) + (voff)[_i]), (PG8_LAS unsigned*)(lds + (bufoff) + ldsw + _i * 8192), 16, 0, 0); } while (0)
#define PG8_LDA(dst, b, h) do { _Pragma("unroll") for (int m = 0; m < 4; ++m) _Pragma("unroll") for (int k = 0; k < 2; ++k) dst[m][k] = *(const PG8_LAS bf16x8*)(lds + PG8_SA(b, h) + aoff + m * 2048 + k * 1024); } while (0)
#define PG8_LDB(dst, b, h) do { _Pragma("unroll") for (int n = 0; n < 2; ++n) _Pragma("unroll") for (int k = 0; k < 2; ++k) dst[n][k] = *(const PG8_LAS bf16x8*)(lds + PG8_SB(b, h) + boff + n * 2048 + k * 1024); } while (0)
#define PG8_MMA(ai, bj, At, Bt) do { __builtin_amdgcn_s_setprio(1); _Pragma("unroll") for (int m = 0; m < 4; ++m) _Pragma("unroll") for (int n = 0; n < 2; ++n) _Pragma("unroll") for (int k = 0; k < 2; ++k) \
        acc[ai][bj][m][n] = __builtin_amdgcn_mfma_f32_16x16x32_bf16(Bt[n][k], At[m][k], acc[ai][bj][m][n], 0, 0, 0); __builtin_amdgcn_s_setprio(0); } while (0)
#define PG8_WAIT_V(n) asm volatile("s_waitcnt vmcnt(" #n ")" ::: "memory")
#define PG8_WAIT_L(n) asm volatile("s_waitcnt lgkmcnt(" #n ")" ::: "memory")
#define PG8_BAR __builtin_amdgcn_s_barrier()
#define PG8_SCHED __builtin_amdgcn_sched_barrier(0)
    Unit cur, nxt; int ui = 0;
    if (!S.next(0, cur)) return;
    f32x4 acc[2][2][4][2];
#pragma unroll
    for (int a = 0; a < 2; ++a)
#pragma unroll
        for (int b = 0; b < 2; ++b)
#pragma unroll
            for (int m = 0; m < 4; ++m)
#pragma unroll
                for (int n = 0; n < 2; ++n) acc[a][b][m][n] = (f32x4){0.f, 0.f, 0.f, 0.f};
    bf16x8 At[4][2], B0[2][2], B1[2][2];
    const char* cA = (const char*)(cur.sel ? g.A2 : g.A) + (size_t)cur.pm * tstep; const char* cB = (const char*)(cur.sel ? g.Bt2 : g.Bt) + (size_t)cur.pn * tstep;
    S.a_ready(cur);
    if constexpr (SP2) {
        PG8_STAGE(PG8_SB(0, 0), cB, voffB); PG8_STAGE(PG8_SB(0, 1), cB + hstep, voffB); PG8_STAGE(PG8_SA(0, 0), cA, voffA); PG8_STAGE(PG8_SA(0, 1), cA + hstep, voffA);
        if (wr == 1) PG8_BAR;
        PG8_WAIT_V(2); PG8_BAR;
        PG8_STAGE(PG8_SB(1, 0), cB + kstep, voffB); PG8_STAGE(PG8_SA(1, 0), cA + kstep, voffA); PG8_STAGE(PG8_SB(1, 1), cB + hstep + kstep, voffB);
        PG8_WAIT_V(6); PG8_BAR;
    } else {
        PG8_STAGE(PG8_SB(0, 0), cB, voffB); PG8_STAGE(PG8_SA(0, 0), cA, voffA); PG8_STAGE(PG8_SB(0, 1), cB + hstep, voffB); PG8_STAGE(PG8_SA(0, 1), cA + hstep, voffA);
        if (wr == 1) PG8_BAR;
        PG8_WAIT_V(4); PG8_BAR;
        PG8_STAGE(PG8_SB(1, 0), cB + kstep, voffB); PG8_STAGE(PG8_SA(1, 0), cA + kstep, voffA); PG8_STAGE(PG8_SB(1, 1), cB + hstep + kstep, voffB);
        PG8_WAIT_V(6); PG8_BAR;
    }
    for (;;) {
        const bool has_next = S.next(ui + 1, nxt);
        const char* nA = has_next ? (const char*)(nxt.sel ? g.A2 : g.A) + (size_t)nxt.pm * tstep : cA; const char* nB = has_next ? (const char*)(nxt.sel ? g.Bt2 : g.Bt) + (size_t)nxt.pn * tstep : cB;
        for (int t = 0; t < nt; t += 2) {
            const bool last = (t == nt - 2);
            const char* a1 = cA + (size_t)(t + 1) * kstep;
            const char* a2 = last ? nA : cA + (size_t)(t + 2) * kstep; const char* b2 = last ? nB : cB + (size_t)(t + 2) * kstep;
            const char* a3 = a2 + kstep; const char* b3 = b2 + kstep;
            if (last && has_next) S.a_ready(nxt);
            if constexpr (SP2) {
            PG8_LDB(B0, 0, 0); PG8_LDB(B1, 0, 1); PG8_SCHED; PG8_LDA(At, 0, 0); PG8_STAGE(PG8_SA(1, 1), a1 + hstep, voffA);
            PG8_WAIT_V(8); PG8_WAIT_L(0); PG8_BAR; PG8_MMA(0, 0, At, B0); PG8_MMA(0, 1, At, B1); PG8_BAR; PG8_SCHED;
            PG8_LDA(At, 0, 1); PG8_STAGE(PG8_SB(0, 0), b2, voffB); PG8_STAGE(PG8_SB(0, 1), b2 + hstep, voffB); PG8_STAGE(PG8_SA(0, 0), a2, voffA);
            PG8_WAIT_V(8); PG8_WAIT_L(0); PG8_BAR; PG8_MMA(1, 0, At, B0); PG8_MMA(1, 1, At, B1); PG8_BAR; PG8_SCHED;
            PG8_LDB(B0, 1, 0); PG8_LDB(B1, 1, 1); PG8_SCHED; PG8_LDA(At, 1, 0); PG8_STAGE(PG8_SA(0, 1), a2 + hstep, voffA);
            PG8_WAIT_V(8); PG8_WAIT_L(0); PG8_BAR; PG8_MMA(0, 0, At, B0); PG8_MMA(0, 1, At, B1); PG8_BAR; PG8_SCHED;
            PG8_LDA(At, 1, 1); PG8_STAGE(PG8_SB(1, 0), b3, voffB); PG8_STAGE(PG8_SB(1, 1), b3 + hstep, voffB); PG8_STAGE(PG8_SA(1, 0), a3, voffA);
            PG8_WAIT_V(8); PG8_WAIT_L(0); PG8_BAR; PG8_MMA(1, 0, At, B0); PG8_MMA(1, 1, At, B1); PG8_BAR; PG8_SCHED;
            } else {
            PG8_LDB(B0, 0, 0); PG8_SCHED; PG8_LDA(At, 0, 0); PG8_STAGE(PG8_SA(1, 1), a1 + hstep, voffA);
            PG8_WAIT_L(8); PG8_BAR; PG8_WAIT_L(0); PG8_MMA(0, 0, At, B0); PG8_BAR; PG8_SCHED;
            PG8_LDB(B1, 0, 1); PG8_STAGE(PG8_SB(0, 0), b2, voffB);
            PG8_BAR; PG8_WAIT_L(0); PG8_MMA(0, 1, At, B1); PG8_BAR;
            PG8_LDA(At, 0, 1); PG8_STAGE(PG8_SA(0, 0), a2, voffA);
            PG8_BAR; PG8_WAIT_L(0); PG8_MMA(1, 0, At, B0); PG8_BAR; PG8_SCHED;
            PG8_STAGE(PG8_SB(0, 1), b2 + hstep, voffB);
            PG8_WAIT_V(6); PG8_BAR; PG8_MMA(1, 1, At, B1); PG8_BAR;
            PG8_LDB(B0, 1, 0); PG8_SCHED; PG8_LDA(At, 1, 0); PG8_STAGE(PG8_SA(0, 1), a2 + hstep, voffA);
            PG8_WAIT_L(8); PG8_BAR; PG8_WAIT_L(0); PG8_MMA(0, 0, At, B0); PG8_BAR; PG8_SCHED;
            PG8_LDB(B1, 1, 1); PG8_STAGE(PG8_SB(1, 0), b3, voffB);
            PG8_BAR; PG8_WAIT_L(0); PG8_MMA(0, 1, At, B1); PG8_BAR;
            PG8_LDA(At, 1, 1); PG8_STAGE(PG8_SA(1, 0), a3, voffA);
            PG8_BAR; PG8_WAIT_L(0); PG8_MMA(1, 0, At, B0); PG8_BAR; PG8_SCHED;
            PG8_STAGE(PG8_SB(1, 1), b3 + hstep, voffB);
            PG8_WAIT_V(6); PG8_BAR; PG8_MMA(1, 1, At, B1); PG8_BAR;
            }
        }
        if constexpr (ALIGN_EPI) { if (wr == 0) PG8_BAR; }
        if constexpr (!Epi::AFTER_DRAIN) { E(acc, cur, wr, wc, fr, fq); S.done(cur); }
        if (!has_next) break;
#pragma unroll
        for (int a = 0; a < 2; ++a)
#pragma unroll
            for (int b = 0; b < 2; ++b)
#pragma unroll
                for (int m = 0; m < 4; ++m)
#pragma unroll
                    for (int n = 0; n < 2; ++n) acc[a][b][m][n] = (f32x4){0.f, 0.f, 0.f, 0.f};
        cur = nxt; cA = nA; cB = nB; ++ui;
        if constexpr (ALIGN_EPI) { if (wr == 1) PG8_BAR; }
    }
    PG8_WAIT_V(0);
    if constexpr (!ALIGN_EPI) { if (wr == 0) PG8_BAR; }
    PG8_BAR;
    if constexpr (Epi::AFTER_DRAIN) { E.fused(acc, cur, wr, wc, fr, fq, lds, wid, lane); S.done(cur); }
#undef PG8_SA
#undef PG8_SB
#undef PG8_STAGE
#undef PG8_LDA
#undef PG8_LDB
#undef PG8_MMA
#undef PG8_WAIT_V
#undef PG8_WAIT_L
#undef PG8_BAR
#undef PG8_SCHED
}
}
#define XB_TMO      128
#define XB_XCNT(j)  (256  + 64 * (j))
#define XB_XSUB(j)  (1280 + 64 * (j))
#define XB_XGEN(j)  (2304 + 64 * (j))
#define XB_TOP      3328
#define XB_TOPGEN   3392
#define XCD_BAR_WORDS 3456
#define XB_SPIN_CAP (1u << 18)

__device__ __forceinline__ unsigned xb_ld(unsigned* p)              { return __hip_atomic_load(p, __ATOMIC_RELAXED, __HIP_MEMORY_SCOPE_AGENT); }
__device__ __forceinline__ unsigned xb_add(unsigned* p, unsigned v) { return __hip_atomic_fetch_add(p, v, __ATOMIC_RELAXED, __HIP_MEMORY_SCOPE_AGENT); }
__device__ __forceinline__ unsigned xb_xcc_id() { return (unsigned)__builtin_amdgcn_s_getreg((3 << 11) | 20) & 0xFu; }
#define XB_SPIN(cond, bar) do { unsigned _sp = 0; while (cond) { __builtin_amdgcn_s_sleep(1); \
    if ((++_sp & 255u) == 0u) { if (xb_ld(&(bar)[XB_TMO])) break; if (_sp > XB_SPIN_CAP) { atomicAdd(&(bar)[XB_TMO], 1u); break; } } } } while (0)

struct XcdBarrier {
    unsigned* bar; unsigned x;
    volatile LAS unsigned* st;
};

__device__ __forceinline__ XcdBarrier xcd_barrier_post(unsigned* bar, volatile LAS unsigned* st) {
    XcdBarrier b; b.bar = bar; b.x = xb_xcc_id(); b.st = st;
    if (threadIdx.x == 0) (void)xb_add(&bar[XB_XCNT(b.x)], 1u);
    return b;
}
__device__ __forceinline__ void xcd_barrier_complete(unsigned* bar, unsigned x, unsigned& nloc, unsigned& nx) {
    const unsigned G = gridDim.x * gridDim.y * gridDim.z;
    unsigned sum, cnt, mine, sp = 0u;
    for (;;) {
        sum = 0u; cnt = 0u; mine = 0u;
#pragma unroll
        for (unsigned j = 0; j < 16; ++j) { const unsigned c = xb_ld(&bar[XB_XCNT(j)]); sum += c; cnt += (c > 0u) ? 1u : 0u; mine = (j == x) ? c : mine; }
        if (sum == G) break;
        __builtin_amdgcn_s_sleep(1);
        if ((++sp & 255u) == 0u) { if (xb_ld(&bar[XB_TMO])) break; if (sp > XB_SPIN_CAP) { atomicAdd(&bar[XB_TMO], 1u); break; } }
    }
    nloc = mine > 0u ? mine : 1u; nx = cnt > 0u ? cnt : 1u;
}

__device__ __forceinline__ void xcd_barrier(const XcdBarrier& b) {
    asm volatile("s_waitcnt vmcnt(0)" ::: "memory");
    __syncthreads();
    if (threadIdx.x == 0) {
        unsigned* bar = b.bar;
        __builtin_amdgcn_s_waitcnt(0);
        unsigned nloc = b.st[0], nx = b.st[1];
        if (nloc == 0u) { xcd_barrier_complete(bar, b.x, nloc, nx); b.st[0] = nloc; b.st[1] = nx; }
        const unsigned old = xb_add(&bar[XB_XSUB(b.x)], 1u);
        const unsigned gen = old / nloc;
        if (old + 1u == (gen + 1u) * nloc) {
            __builtin_amdgcn_fence(__ATOMIC_RELEASE, "agent");
            asm volatile("s_waitcnt vmcnt(0)" ::: "memory");
            const unsigned og = xb_add(&bar[XB_TOP], 1u);
            const unsigned tg = og / nx;
            if (og + 1u == (tg + 1u) * nx) xb_add(&bar[XB_TOPGEN], 1u);
            else XB_SPIN(xb_ld(&bar[XB_TOPGEN]) == tg, bar);
            __builtin_amdgcn_fence(__ATOMIC_ACQUIRE, "agent");
            xb_add(&bar[XB_XGEN(b.x)], 1u);
            asm volatile("s_waitcnt vmcnt(0)" ::: "memory");
        } else {
            XB_SPIN(xb_ld(&bar[XB_XGEN(b.x)]) == gen, bar);
            __builtin_amdgcn_fence(__ATOMIC_ACQUIRE, "agent");
            asm volatile("s_waitcnt vmcnt(0)" ::: "memory");
        }
    }
    __syncthreads();
}
namespace attn {
using namespace cfg;
constexpr int SLOTB = 8192, LDS_K = 0, LDS_V = 4 * SLOTB, LDS_WS = 8 * SLOTB, LDS_OST = LDS_WS + 8 * 64 * 4, LDS_BYTES = LDS_OST + 8 * 4096;
typedef __attribute__((address_space(3))) const char* lds_cptr;
typedef short v4i16_t __attribute__((ext_vector_type(4)));
__device__ __forceinline__ int crow(int r, int hi) { return (r & 3) + 8 * (r >> 2) + 4 * hi; }
__device__ __forceinline__ void glds16(const void* gsrc, unsigned lds_dst) { unsigned keep;
    asm volatile("s_mov_b32 %0, m0\n\ts_mov_b32 m0, %2\n\ts_nop 0\n\tglobal_load_lds_dwordx4 %1, off\n\ts_mov_b32 m0, %0" : "=&s"(keep) : "v"(gsrc), "s"(lds_dst) : "memory"); }
__device__ __forceinline__ s16x4 vtr(lds_cptr p) { return __builtin_bit_cast(s16x4, __builtin_amdgcn_ds_read_tr16_b64_v4i16((__attribute__((address_space(3))) v4i16_t*)p)); }
__device__ __forceinline__ float swapmax(float m) { auto rr = __builtin_amdgcn_permlane32_swap(__float_as_uint(m), __float_as_uint(m), false, false); return fmaxf(__uint_as_float(rr[0]), __uint_as_float(rr[1])); }
__device__ __forceinline__ float swapadd(float m) { auto rr = __builtin_amdgcn_permlane32_swap(__float_as_uint(m), __float_as_uint(m), false, false); return __uint_as_float(rr[0]) + __uint_as_float(rr[1]); }
#define ATT_WAIT_BAR() asm volatile("s_waitcnt vmcnt(0) lgkmcnt(0)\n\ts_barrier" ::: "memory")

__device__ __forceinline__ void attn_unit(int b, int hkv, int nb, const bf16* QA, const bf16* KVA, bf16* AO, const float* sinks, char* shm) {
    const int tid = threadIdx.x, lane = tid & 63, r32 = lane & 31, hi = lane >> 5; const int wid = __builtin_amdgcn_readfirstlane(tid >> 6);
    const int g = wid >> 1, ph = wid & 1, hq = hkv * 4 + g;
    const long rowbase = (long)b * SEQ; const unsigned lds0 = (unsigned)(uintptr_t)shm;
#pragma unroll
    for (int sl = 0; sl < 4; ++sl) {
        if (nb == 0 && sl < 2) { *(v4u*)(shm + LDS_K + sl * SLOTB + wid * 1024 + lane * 16) = (v4u){0u, 0u, 0u, 0u}; *(v4u*)(shm + LDS_V + sl * SLOTB + wid * 1024 + lane * 16) = (v4u){0u, 0u, 0u, 0u}; }
        else { const long k0 = rowbase + nb * 128 - 128 + 64 * sl;
            const bf16* ksrc = KVA + (k0 + lane) * 256 + hkv * 64 + wid * 8;
            const bf16* vsrc = KVA + (k0 + 16 * (wid & 3) + (lane >> 2)) * 256 + 128 + hkv * 64 + (wid >> 2) * 32 + (lane & 3) * 8;
            glds16(ksrc, (unsigned)__builtin_amdgcn_readfirstlane(lds0 + LDS_K + sl * SLOTB + wid * 1024)); glds16(vsrc, (unsigned)__builtin_amdgcn_readfirstlane(lds0 + LDS_V + sl * SLOTB + wid * 1024)); }
    }
    const bf16* Qw = QA + (rowbase + nb * 128 + 64 * ph) * 512 + hq * 64;
    bf16x8 qr[2][4];
#pragma unroll
    for (int qb = 0; qb < 2; ++qb)
#pragma unroll
        for (int d0 = 0; d0 < 4; ++d0) qr[qb][d0] = *reinterpret_cast<const bf16x8*>(Qw + (long)(32 * qb + r32) * 512 + d0 * 16 + hi * 8);
    const float slope2 = exp2f(-(float)(hq + 1)) * LOG2E, sink2 = sinks[hq] * LOG2E;
    float* wsf = (float*)(shm + LDS_WS) + wid * 64;
    const lds_cptr shm3 = (lds_cptr)shm; const lds_cptr vp0 = shm3 + LDS_V + ((lane >> 4) & 1) * 32 + (lane & 3) * 8 + (4 * hi + ((lane & 15) >> 2)) * 64;
    ATT_WAIT_BAR();
#pragma unroll
    for (int qb = 0; qb < 2; ++qb) {
        const int kb0 = 2 * ph + qb;
        f32x16 S[5];
#pragma unroll
        for (int j = 0; j < 5; ++j) { const int kb = kb0 + j; const char* kbase = shm + LDS_K + (kb >> 1) * SLOTB + hi * 1024 + ((kb & 1) * 32 + r32) * 16;
            S[j] = f32x16{};
#pragma unroll
            for (int d0 = 0; d0 < 4; ++d0) { const bf16x8 kf = *reinterpret_cast<const bf16x8*>(kbase + d0 * 2048); S[j] = __builtin_amdgcn_mfma_f32_32x32x16_bf16(kf, qr[qb][d0], S[j], 0, 0, 0); } }
        float mx = sink2;
#pragma unroll
        for (int j = 0; j < 5; ++j) { const bool dead = (nb == 0) && (kb0 + j < 4);
#pragma unroll
            for (int r = 0; r < 16; ++r) { const int cr = crow(r, hi); const int dist = 128 + r32 - 32 * j - cr; float s = S[j][r] - slope2 * (float)dist;
                bool ok = !dead; if (j == 0) ok = ok && (cr > r32); if (j == 4) ok = ok && (cr <= r32);
                s = ok ? s : -INFINITY; S[j][r] = s; mx = fmaxf(mx, s); } }
        mx = swapmax(mx);
        float l = 0.f;
#pragma unroll
        for (int j = 0; j < 5; ++j)
#pragma unroll
            for (int r = 0; r < 16; ++r) { const float p = __builtin_amdgcn_exp2f(S[j][r] - mx); S[j][r] = p; l += p; }
        l = swapadd(l) + __builtin_amdgcn_exp2f(sink2 - mx);
        f32x16 o[2]; o[0] = f32x16{}; o[1] = f32x16{};
#pragma unroll
        for (int j = 0; j < 5; ++j) { const int kb = kb0 + j; const lds_cptr vb = vp0 + (kb >> 1) * SLOTB;
#pragma unroll
            for (int s2 = 0; s2 < 2; ++s2) { const int ks = (kb & 1) * 2 + s2;
                v4u pw; pw.x = cvtpk(S[j][8 * s2 + 0], S[j][8 * s2 + 1]); pw.y = cvtpk(S[j][8 * s2 + 2], S[j][8 * s2 + 3]); pw.z = cvtpk(S[j][8 * s2 + 4], S[j][8 * s2 + 5]); pw.w = cvtpk(S[j][8 * s2 + 6], S[j][8 * s2 + 7]);
                const bf16x8 pa = __builtin_bit_cast(bf16x8, pw);
#pragma unroll
                for (int d0 = 0; d0 < 2; ++d0) { const s16x4 lo = vtr(vb + d0 * 4096 + ks * 1024), hh = vtr(vb + d0 * 4096 + ks * 1024 + 512);
                    const bf16x8 vf = (bf16x8){lo[0], lo[1], lo[2], lo[3], hh[0], hh[1], hh[2], hh[3]};
                    o[d0] = __builtin_amdgcn_mfma_f32_32x32x16_bf16(pa, vf, o[d0], 0, 0, 0); } } }
        if (hi == 0) wsf[32 + r32] = l; asm volatile("s_waitcnt lgkmcnt(0)" ::: "memory");
        float rli[16];
#pragma unroll
        for (int r = 0; r < 16; ++r) rli[r] = __builtin_amdgcn_rcpf(wsf[32 + crow(r, hi)]);
        bf16* Ow = AO + (rowbase + nb * 128 + 64 * ph + 32 * qb) * 512 + hq * 64;
        bf16* stg = (bf16*)(shm + LDS_OST) + wid * 2048;
#pragma unroll
        for (int r = 0; r < 16; ++r) { const int orow = crow(r, hi);
#pragma unroll
            for (int d0 = 0; d0 < 2; ++d0) stg[orow * 64 + d0 * 32 + r32] = (bf16)f2bf(o[d0][r] * rli[r]); }
        asm volatile("s_waitcnt lgkmcnt(0)" ::: "memory");
#pragma unroll
        for (int i = 0; i < 4; ++i) { const int row = i * 8 + (lane >> 3), ch = lane & 7; const v4u v = *(const v4u*)(stg + row * 64 + ch * 8); *(v4u*)(Ow + (long)row * 512 + ch * 8) = v; }
        asm volatile("s_waitcnt lgkmcnt(0)" ::: "memory");
    }
    asm volatile("s_waitcnt lgkmcnt(0)\n\ts_barrier" ::: "memory");
}
__device__ __forceinline__ void attn_phase(char* lds, int vcu, int G, const bf16* QA, const bf16* KVA, bf16* AO, const float* sinks) {
    for (int u = vcu; u < BATCH * 2 * 32; u += G) { const int b = u >> 6, hkv = (u >> 5) & 1, nb = u & 31; attn_unit(b, hkv, nb, QA, KVA, AO, sinks, lds); }
}
#undef ATT_WAIT_BAR
}
namespace mlstm {
using namespace cfg;
using attn::glds16; using attn::vtr; using attn::crow; using attn::swapadd; using attn::lds_cptr;
constexpr int MS_GC = 0, MS_MLOC = 1024, MS_MST = 2048, MS_NLOC = 4096, MS_NST = 4096 + 65536;
#define ML_WAIT_BAR() asm volatile("s_waitcnt vmcnt(0) lgkmcnt(0)\n\ts_barrier" ::: "memory")
#define ML_LDS_BAR() asm volatile("s_waitcnt lgkmcnt(0)\n\ts_barrier" ::: "memory")

__device__ __forceinline__ void dma_v_chunk(const bf16* MV, long row0, int h, unsigned lds_v, int wid, int lane) {
#pragma unroll
    for (int sl = 0; sl < 4; ++sl) { const int sh = sl >> 1, dvh = sl & 1;
        const bf16* src = MV + (row0 + 64 * sh + 16 * (wid & 3) + (lane >> 2)) * 512 + h * 128 + 64 * dvh + 32 * (wid >> 2) + (lane & 3) * 8;
        glds16(src, (unsigned)__builtin_amdgcn_readfirstlane(lds_v + sl * 8192 + wid * 1024)); }
}
__device__ __forceinline__ void gate_scan(const float* GATES, long row0, int h, float ibh, float fbh, int lane, float& b2a, float& b2b, float& u2a, float& u2b) {
    const float* g0 = GATES + (row0 + 2 * lane) * 8; const float ia = g0[h] + ibh, fa = g0[4 + h] + fbh, ib_ = g0[8 + h] + ibh, fb_ = g0[12 + h] + fbh;
    const float la = logsigmoidf_(fa), lb = logsigmoidf_(fb_);
    float inc = la + lb;
#pragma unroll
    for (int d = 1; d < 64; d <<= 1) { const float t = __shfl_up(inc, d); if (lane >= d) inc += t; }
    const float ba = inc - lb, bb = inc;
    b2a = ba * LOG2E; b2b = bb * LOG2E; u2a = (ia - ba) * LOG2E; u2b = (ib_ - bb) * LOG2E;
}

constexpr int A_KT = 0, A_KT_PITCH = 272, A_V = 17408, A_W = A_V + 32768, A_NP = A_W + 512, A_BYTES = A_NP + 2048;
__device__ __forceinline__ void item_a(int item, const bf16* MQK, const bf16* MV, const float* GATES, const float* cw, const float* cb, const float* ib, const float* fb, float* CLOC, float* MSM, char* shm) {
    const int tid = threadIdx.x, lane = tid & 63, r32 = lane & 31, hi = lane >> 5; const int wid = __builtin_amdgcn_readfirstlane(tid >> 6);
    const int c = item & 31, h = (item >> 5) & 3, b = item >> 7, t0 = c * 128; const long row0 = (long)b * SEQ + t0; const unsigned lds0 = (unsigned)(uintptr_t)shm;
    dma_v_chunk(MV, row0, h, lds0 + A_V, wid, lane);
    float* W = (float*)(shm + A_W); float* NP = (float*)(shm + A_NP);
    if (wid == 0) { float b2a, b2b, u2a, u2b; gate_scan(GATES, row0, h, ib[h], fb[h], lane, b2a, b2b, u2a, u2b);
        float um = fmaxf(u2a, u2b);
#pragma unroll
        for (int o = 1; o < 64; o <<= 1) um = fmaxf(um, __shfl_xor(um, o));
        const float G2 = __shfl(b2b, 63);
        W[2 * lane] = __builtin_amdgcn_exp2f(u2a - um); W[2 * lane + 1] = __builtin_amdgcn_exp2f(u2b - um);
        if (lane == 0) { MSM[MS_GC + item] = G2 * (1.f / LOG2E); MSM[MS_MLOC + item] = (G2 + um) * (1.f / LOG2E); } }
    const int ch = 256 + h * 64 + lane;
    float xin[19];
#pragma unroll
    for (int i = 0; i < 19; ++i) { const int t = t0 + 16 * wid - 3 + i; xin[i] = (t >= 0) ? bf2f(MQK[((long)b * SEQ + t) * 512 + ch]) : 0.f; }
    const float w0 = cw[ch], w1 = cw[512 + ch], w2 = cw[1024 + ch], w3 = cw[1536 + ch], cbv = cb[ch];
    float kv[16];
#pragma unroll
    for (int i = 0; i < 16; ++i) { const float a = cbv + w0 * xin[i] + w1 * xin[i + 1] + w2 * xin[i + 2] + w3 * xin[i + 3]; kv[i] = 0.125f * a * fast_sigmoid(a); }
    ML_LDS_BAR();
    float np = 0.f;
#pragma unroll
    for (int i = 0; i < 16; ++i) { kv[i] *= W[16 * wid + i]; np += kv[i]; }
    NP[wid * 64 + lane] = np;
    { v4u p0, p1; p0.x = cvtpk(kv[0], kv[1]); p0.y = cvtpk(kv[2], kv[3]); p0.z = cvtpk(kv[4], kv[5]); p0.w = cvtpk(kv[6], kv[7]); p1.x = cvtpk(kv[8], kv[9]); p1.y = cvtpk(kv[10], kv[11]); p1.z = cvtpk(kv[12], kv[13]); p1.w = cvtpk(kv[14], kv[15]);
        *(v4u*)(shm + A_KT + lane * A_KT_PITCH + wid * 32) = p0; *(v4u*)(shm + A_KT + lane * A_KT_PITCH + wid * 32 + 16) = p1; }
    ML_WAIT_BAR();
    if (tid < 64) { float a = 0.f;
#pragma unroll
        for (int w = 0; w < 8; ++w) a += NP[w * 64 + tid];
        MSM[MS_NLOC + item * 64 + tid] = a; }
    const int rb = wid & 1, cb4 = wid >> 1;
    f32x16 acc = f32x16{};
    const lds_cptr vp = (lds_cptr)shm + A_V + (cb4 >> 1) * 8192 + (cb4 & 1) * 4096 + ((lane >> 4) & 1) * 32 + (lane & 3) * 8 + (8 * hi + ((lane & 15) >> 2)) * 64;
#pragma unroll
    for (int ks = 0; ks < 8; ++ks) {
        const bf16x8 af = *reinterpret_cast<const bf16x8*>(shm + A_KT + (32 * rb + r32) * A_KT_PITCH + (16 * ks + 8 * hi) * 2);
        const lds_cptr vb = vp + (ks >> 2) * 16384 + (ks & 3) * 1024; const s16x4 lo = vtr(vb), hh = vtr(vb + 256);
        const bf16x8 vf = (bf16x8){lo[0], lo[1], lo[2], lo[3], hh[0], hh[1], hh[2], hh[3]};
        acc = __builtin_amdgcn_mfma_f32_32x32x16_bf16(af, vf, acc, 0, 0, 0); }
    float* Co = CLOC + ((size_t)item * 64 + 32 * rb) * 128 + 32 * cb4 + r32;
#pragma unroll
    for (int r = 0; r < 16; ++r) Co[crow(r, hi) * 128] = acc[r];
    ML_LDS_BAR();
}

__device__ __forceinline__ void phase_b(int vcu, int G, const float* CLOC, bf16* CST, float* MSM) {
    const int tid = threadIdx.x;
    for (int gid = vcu * 512 + tid; gid < 32 * 4096; gid += G * 512) { const int bh = gid >> 12, e2 = gid & 4095;
        f32x2 cl[32];
#pragma unroll
        for (int c = 0; c < 32; ++c) cl[c] = *(const f32x2*)(CLOC + (size_t)(bh * 32 + c) * 8192 + 2 * e2);
        float m = 0.f; f32x2 C = {0.f, 0.f};
#pragma unroll
        for (int c = 0; c < 32; ++c) { const int item = bh * 32 + c; const float Gc = MSM[MS_GC + item], ml = MSM[MS_MLOC + item];
            const float mn = fmaxf(Gc + m, ml), dec = __expf(Gc + m - mn), sc = __expf(ml - mn);
            *(unsigned*)(CST + (size_t)item * 8192 + 2 * e2) = cvtpk(C.x, C.y);
            C = C * dec + cl[c] * sc; m = mn; } }
    for (int gid = vcu * 512 + tid; gid < 32 * 64; gid += G * 512) { const int bh = gid >> 6, k = gid & 63;
        float m = 0.f, n = 0.f;
        for (int c = 0; c < 32; ++c) { const int item = bh * 32 + c; const float Gc = MSM[MS_GC + item], ml = MSM[MS_MLOC + item];
            const float mn = fmaxf(Gc + m, ml), dec = __expf(Gc + m - mn), sc = __expf(ml - mn);
            MSM[MS_NST + item * 64 + k] = n; if (k == 0) MSM[MS_MST + item] = m;
            n = n * dec + MSM[MS_NLOC + item * 64 + k] * sc; m = mn; } }
}

constexpr int C_Q = 0, C_K = 16384, C_V = 32768, C_CS = 65536, C_U2 = 81920, C_MT2 = C_U2 + 512, C_BT2 = C_MT2 + 512, C_NS = C_BT2 + 512, C_DEN = C_NS + 256, C_BYTES = C_DEN + 512, C_STG = 0;
__device__ __forceinline__ void item_c(int item, const bf16* MQK, const bf16* MV, const bf16* MO, const float* GATES, const float* cw, const float* cb, const float* ib, const float* fb, const float* gmn,
                                       const bf16* CST, const float* MSM, bf16* HN, char* shm) {
    const int tid = threadIdx.x, lane = tid & 63, r32 = lane & 31, hi = lane >> 5; const int wid = __builtin_amdgcn_readfirstlane(tid >> 6);
    const int c = item & 31, h = (item >> 5) & 3, b = item >> 7, t0 = c * 128; const long row0 = (long)b * SEQ + t0; const unsigned lds0 = (unsigned)(uintptr_t)shm;
    dma_v_chunk(MV, row0, h, lds0 + C_V, wid, lane);
#pragma unroll
    for (int dvh = 0; dvh < 2; ++dvh) { const bf16* src = CST + (size_t)item * 8192 + (16 * (wid & 3) + (lane >> 2)) * 128 + 64 * dvh + 32 * (wid >> 2) + (lane & 3) * 8;
        glds16(src, (unsigned)__builtin_amdgcn_readfirstlane(lds0 + C_CS + dvh * 8192 + wid * 1024)); }
    float* U2 = (float*)(shm + C_U2); float* MT2 = (float*)(shm + C_MT2); float* BT2 = (float*)(shm + C_BT2); float* NS = (float*)(shm + C_NS); float* DEN = (float*)(shm + C_DEN);
    const float ms2 = MSM[MS_MST + item] * LOG2E;
    if (wid == 0) { float b2a, b2b, u2a, u2b; gate_scan(GATES, row0, h, ib[h], fb[h], lane, b2a, b2b, u2a, u2b);
        float inc = fmaxf(u2a, u2b);
#pragma unroll
        for (int d = 1; d < 64; d <<= 1) { const float t = __shfl_up(inc, d); if (lane >= d) inc = fmaxf(inc, t); }
        float exc = __shfl_up(inc, 1); if (lane == 0) exc = -INFINITY;
        U2[2 * lane] = u2a; U2[2 * lane + 1] = u2b; BT2[2 * lane] = b2a; BT2[2 * lane + 1] = b2b;
        MT2[2 * lane] = fmaxf(ms2, fmaxf(exc, u2a)); MT2[2 * lane + 1] = fmaxf(ms2, inc);
        NS[lane] = MSM[MS_NST + item * 64 + lane]; }
    { const int isk = tid >> 8, rem = tid & 255, chn = rem & 7, sg = rem >> 3, ch0 = isk * 256 + h * 64 + chn * 8;
        float xin[7][8];
#pragma unroll
        for (int i = 0; i < 7; ++i) { const int t = t0 + 4 * sg - 3 + i; v4u raw = {0u, 0u, 0u, 0u}; if (t >= 0) raw = *(const v4u*)(MQK + ((long)b * SEQ + t) * 512 + ch0);
            xin[i][0] = __builtin_bit_cast(float, raw.x << 16); xin[i][1] = __builtin_bit_cast(float, raw.x & 0xffff0000u); xin[i][2] = __builtin_bit_cast(float, raw.y << 16); xin[i][3] = __builtin_bit_cast(float, raw.y & 0xffff0000u);
            xin[i][4] = __builtin_bit_cast(float, raw.z << 16); xin[i][5] = __builtin_bit_cast(float, raw.z & 0xffff0000u); xin[i][6] = __builtin_bit_cast(float, raw.w << 16); xin[i][7] = __builtin_bit_cast(float, raw.w & 0xffff0000u); }
        float wv[4][8], bv[8];
#pragma unroll
        for (int e = 0; e < 8; ++e) { bv[e] = cb[ch0 + e];
#pragma unroll
            for (int j = 0; j < 4; ++j) wv[j][e] = cw[j * 512 + ch0 + e]; }
        const float scl = isk ? 0.125f : 1.f;
#pragma unroll
        for (int i = 0; i < 4; ++i) { float o[8];
#pragma unroll
            for (int e = 0; e < 8; ++e) { const float a = bv[e] + wv[0][e] * xin[i][e] + wv[1][e] * xin[i + 1][e] + wv[2][e] * xin[i + 2][e] + wv[3][e] * xin[i + 3][e]; o[e] = scl * a * fast_sigmoid(a); }
            v4u p; p.x = cvtpk(o[0], o[1]); p.y = cvtpk(o[2], o[3]); p.z = cvtpk(o[4], o[5]); p.w = cvtpk(o[6], o[7]);
            *(v4u*)(shm + (isk ? C_K : C_Q) + chn * 2048 + (4 * sg + i) * 16) = p; } }
    ML_WAIT_BAR();
    const int tb = wid & 3, dvh = wid >> 2, tl = 32 * tb + r32;
    bf16x8 qf[4];
#pragma unroll
    for (int d0 = 0; d0 < 4; ++d0) qf[d0] = *reinterpret_cast<const bf16x8*>(shm + C_Q + (2 * d0 + hi) * 2048 + tl * 16);
    const float Mt2 = MT2[tl], winter = __builtin_amdgcn_exp2f(ms2 - Mt2);
    f32x16 o[2]; o[0] = f32x16{}; o[1] = f32x16{};
    float rowsum = 0.f;
    const lds_cptr vpp = (lds_cptr)shm + C_V + dvh * 8192 + ((lane >> 4) & 1) * 32 + (lane & 3) * 8 + (4 * hi + ((lane & 15) >> 2)) * 64;
#pragma unroll 1
    for (int sb = 0; sb <= tb; ++sb) {
        f32x16 S = f32x16{};
#pragma unroll
        for (int d0 = 0; d0 < 4; ++d0) { const bf16x8 kf = *reinterpret_cast<const bf16x8*>(shm + C_K + (2 * d0 + hi) * 2048 + (32 * sb + r32) * 16); S = __builtin_amdgcn_mfma_f32_32x32x16_bf16(kf, qf[d0], S, 0, 0, 0); }
        const bool diag = (sb == tb);
#pragma unroll
        for (int i = 0; i < 4; ++i) { const f32x4 u4 = *(const f32x4*)(U2 + 32 * sb + 8 * i + 4 * hi);
#pragma unroll
            for (int e = 0; e < 4; ++e) { const int r = 4 * i + e; const float wgt = __builtin_amdgcn_exp2f(u4[e] - Mt2); float p = S[r] * wgt; if (diag && (crow(r, hi) > r32)) p = 0.f; S[r] = p; rowsum += p; } }
#pragma unroll
        for (int s2 = 0; s2 < 2; ++s2) { const int ks = 2 * sb + s2;
            v4u pw; pw.x = cvtpk(S[8 * s2 + 0], S[8 * s2 + 1]); pw.y = cvtpk(S[8 * s2 + 2], S[8 * s2 + 3]); pw.z = cvtpk(S[8 * s2 + 4], S[8 * s2 + 5]); pw.w = cvtpk(S[8 * s2 + 6], S[8 * s2 + 7]);
            const bf16x8 pa = __builtin_bit_cast(bf16x8, pw);
#pragma unroll
            for (int d0 = 0; d0 < 2; ++d0) { const lds_cptr vb = vpp + (ks >> 2) * 16384 + d0 * 4096 + (ks & 3) * 1024; const s16x4 lo = vtr(vb), hh = vtr(vb + 512);
                const bf16x8 vf = (bf16x8){lo[0], lo[1], lo[2], lo[3], hh[0], hh[1], hh[2], hh[3]};
                o[d0] = __builtin_amdgcn_mfma_f32_32x32x16_bf16(pa, vf, o[d0], 0, 0, 0); } }
    }
    float qn = 0.f;
    { const lds_cptr cp = (lds_cptr)shm + C_CS + dvh * 8192 + ((lane >> 4) & 1) * 32 + (lane & 3) * 8 + (8 * hi + ((lane & 15) >> 2)) * 64;
#pragma unroll
        for (int ks = 0; ks < 4; ++ks) { float qv[8]; const v4u raw = __builtin_bit_cast(v4u, qf[ks]);
            qv[0] = __builtin_bit_cast(float, raw.x << 16); qv[1] = __builtin_bit_cast(float, raw.x & 0xffff0000u); qv[2] = __builtin_bit_cast(float, raw.y << 16); qv[3] = __builtin_bit_cast(float, raw.y & 0xffff0000u);
            qv[4] = __builtin_bit_cast(float, raw.z << 16); qv[5] = __builtin_bit_cast(float, raw.z & 0xffff0000u); qv[6] = __builtin_bit_cast(float, raw.w << 16); qv[7] = __builtin_bit_cast(float, raw.w & 0xffff0000u);
            const f32x4 n0 = *(const f32x4*)(NS + 16 * ks + 8 * hi), n1 = *(const f32x4*)(NS + 16 * ks + 8 * hi + 4);
            qn += (qv[0] * n0[0] + qv[1] * n0[1]) + (qv[2] * n0[2] + qv[3] * n0[3]) + (qv[4] * n1[0] + qv[5] * n1[1]) + (qv[6] * n1[2] + qv[7] * n1[3]);
            v4u qw; qw.x = cvtpk(qv[0] * winter, qv[1] * winter); qw.y = cvtpk(qv[2] * winter, qv[3] * winter); qw.z = cvtpk(qv[4] * winter, qv[5] * winter); qw.w = cvtpk(qv[6] * winter, qv[7] * winter);
            const bf16x8 qa = __builtin_bit_cast(bf16x8, qw);
#pragma unroll
            for (int d0 = 0; d0 < 2; ++d0) { const lds_cptr cbp = cp + d0 * 4096 + ks * 1024; const s16x4 lo = vtr(cbp), hh = vtr(cbp + 256);
                const bf16x8 cf = (bf16x8){lo[0], lo[1], lo[2], lo[3], hh[0], hh[1], hh[2], hh[3]};
                o[d0] = __builtin_amdgcn_mfma_f32_32x32x16_bf16(qa, cf, o[d0], 0, 0, 0); } } }
    rowsum = swapadd(rowsum); qn = swapadd(qn);
    { const float nq = rowsum + winter * qn, mt2 = BT2[tl] + Mt2; const float den = fmaxf(fabsf(nq), __builtin_amdgcn_exp2f(-mt2));
        if (dvh == 0 && hi == 0) DEN[tl] = 1.f / den; }
    ML_LDS_BAR();
    float* STG = (float*)(shm + C_STG);
#pragma unroll
    for (int r = 0; r < 16; ++r)
#pragma unroll
        for (int d0 = 0; d0 < 2; ++d0) STG[(32 * tb + crow(r, hi)) * 128 + 64 * dvh + 32 * d0 + r32] = o[d0][r];
    ML_LDS_BAR();
#pragma unroll
    for (int i = 0; i < 4; ++i) { const int idx = tid + 512 * i, t = idx >> 4, chn = idx & 15;
        const f32x4 a0 = *(const f32x4*)(STG + t * 128 + 8 * chn), a1 = *(const f32x4*)(STG + t * 128 + 8 * chn + 4); const float dn = DEN[t];
        const f32x4 h0 = a0 * dn, h1 = a1 * dn;
        float ss = (h0[0] * h0[0] + h0[1] * h0[1]) + (h0[2] * h0[2] + h0[3] * h0[3]) + (h1[0] * h1[0] + h1[1] * h1[1]) + (h1[2] * h1[2] + h1[3] * h1[3]);
        ss += __shfl_xor(ss, 1); ss += __shfl_xor(ss, 2); ss += __shfl_xor(ss, 4); ss += __shfl_xor(ss, 8);
        const float rn = rsqrtf(ss * (1.f / 128.f) + EPS);
        const f32x4 g0 = *(const f32x4*)(gmn + h * 128 + 8 * chn), g1 = *(const f32x4*)(gmn + h * 128 + 8 * chn + 4);
        const v4u mo = *(const v4u*)(MO + (row0 + t) * 512 + h * 128 + 8 * chn);
        f32x4 m0, m1; m0[0] = __builtin_bit_cast(float, mo.x << 16); m0[1] = __builtin_bit_cast(float, mo.x & 0xffff0000u); m0[2] = __builtin_bit_cast(float, mo.y << 16); m0[3] = __builtin_bit_cast(float, mo.y & 0xffff0000u);
        m1[0] = __builtin_bit_cast(float, mo.z << 16); m1[1] = __builtin_bit_cast(float, mo.z & 0xffff0000u); m1[2] = __builtin_bit_cast(float, mo.w << 16); m1[3] = __builtin_bit_cast(float, mo.w & 0xffff0000u);
        const f32x4 y0 = h0 * rn * g0 * m0, y1 = h1 * rn * g1 * m1;
        v4u p; p.x = cvtpk(y0[0], y0[1]); p.y = cvtpk(y0[2], y0[3]); p.z = cvtpk(y1[0], y1[1]); p.w = cvtpk(y1[2], y1[3]);
        *(v4u*)(HN + (row0 + t) * 512 + h * 128 + 8 * chn) = p; }
    ML_LDS_BAR();
}
__device__ __forceinline__ void phase_a(char* lds, int vcu, int G, const bf16* MQK, const bf16* MV, const float* GATES, const float* cw, const float* cb, const float* ib, const float* fb, float* CLOC, float* MSM) {
    for (int it = vcu; it < 1024; it += G) item_a(it, MQK, MV, GATES, cw, cb, ib, fb, CLOC, MSM, lds);
}
__device__ __forceinline__ void phase_c(char* lds, int vcu, int G, const bf16* MQK, const bf16* MV, const bf16* MO, const float* GATES, const float* cw, const float* cb, const float* ib, const float* fb, const float* gmn,
                                        const bf16* CST, const float* MSM, bf16* HN) {
    for (int it = vcu; it < 1024; it += G) item_c(it, MQK, MV, MO, GATES, cw, cb, ib, fb, gmn, CST, MSM, HN, lds);
}
#undef ML_WAIT_BAR
#undef ML_LDS_BAR
}
namespace mk {
using namespace cfg;
constexpr int NWAVES = 8, NTHREADS = 512;
constexpr int RING_OFF = 0, RING_BYTES = 131072;
constexpr int LDSCTL_OFF = RING_BYTES, MISC_OFF = LDSCTL_OFF + 320;
constexpr int LDS_BYTES = 147456;
constexpr int CW_TMO = 0, CW_CODE = 1, CW_BAR = 4096, N_BAR_REGIONS = 8;
static_assert((CW_BAR + N_BAR_REGIONS * XCD_BAR_WORDS) * 4 <= (int)MiB, "CTL words inside the memset region");
constexpr size_t WS_SS1X = 4 * MiB;
enum Phase { P_PRO = 0, P_G1, P_MIX_A, P_SCAN, P_MIX_C, P_G2, P_G3, P_G4, P_G5, P_FIN, N_PHASES };

struct Args { const float* in[17]; float* out; unsigned char* ws; int ph_lo, ph_hi, li, pad; };

struct Frame {
    LAS unsigned char* lds; volatile LAS unsigned* MISC; gu32* ctl;
    int tid, lane, wave, vcu, G;
};

__device__ __forceinline__ float wave_sum(float v) {
#pragma unroll
    for (int o = 1; o < 64; o <<= 1) v += __shfl_xor(v, o);
    return v;
}

__device__ __forceinline__ void p0_transpose_item(const float* W, int ldw, int src_c0, const float* scale, bf16* WT, int K, int dst_r0, int kb, LAS float* scr, int lane) {
    const int k0 = 64 * kb;
#pragma unroll 8
    for (int i = 0; i < 32; ++i) { const int kk = 2 * i + (lane >> 5); float v = W[(size_t)(k0 + kk) * ldw + src_c0 + (lane & 31)]; if (scale) v *= scale[k0 + kk]; scr[kk * 33 + (lane & 31)] = v; }
    LDS_WAIT(); asm volatile("" ::: "memory");
    const int c = lane & 7;
#pragma unroll
    for (int j = 0; j < 4; ++j) { const int n = (lane >> 3) + 8 * j; const LAS float* s = scr + (8 * c) * 33 + n;
        v4u o; o.x = pk2(s[0 * 33], s[1 * 33]); o.y = pk2(s[2 * 33], s[3 * 33]); o.z = pk2(s[4 * 33], s[5 * 33]); o.w = pk2(s[6 * 33], s[7 * 33]);
        *(GAS v4u*)(WT + (size_t)(dst_r0 + n) * K + k0 + 8 * c) = o; }
    LDS_WAIT(); asm volatile("" ::: "memory");
}
__device__ __forceinline__ void p0_prologue(Frame& F, const Args& a) {
    LAS float* scr = (LAS float*)(F.lds + RING_OFF + F.wave * 16384);
    const int gw = F.vcu * NWAVES + F.wave, NGW = F.G * NWAVES;
    unsigned char* ws = a.ws;
    constexpr int I0 = 16 * 72, I1 = 16 * 64, I2 = 8 * 32, I3 = 8 * 32, I4 = 16 * 32, I5 = 16 * 88, I6 = 16 * 88, I7 = 44 * 32;
    constexpr int NITEMS = I0 + I1 + I2 + I3 + I4 + I5 + I6 + I7;
    for (int it = gw; it < NITEMS; it += NGW) {
        int r = it;
        if (r < I0) { const int kb = r / 72, nb = r % 72; p0_transpose_item(a.in[2], INW, 32 * nb, nullptr, (bf16*)(ws + WS_WIN), 1024, 32 * nb, kb, scr, F.lane); continue; } r -= I0;
        if (r < I1) { const int kb = r / 64, nb = r % 64; p0_transpose_item(a.in[2], INW, C_GA + 32 * nb, nullptr, (bf16*)(ws + WS_WIN), 1024, 2304 + 32 * nb, kb, scr, F.lane); continue; } r -= I1;
        if (r < I2) { const int kb = r / 32, nb = r % 32; p0_transpose_item(a.in[9], 1024, 32 * nb, nullptr, (bf16*)(ws + WS_WA), 512, 32 * nb, kb, scr, F.lane); continue; } r -= I2;
        if (r < I3) { const int kb = r / 32, nb = r % 32; p0_transpose_item(a.in[10], 1024, 32 * nb, nullptr, (bf16*)(ws + WS_WM), 512, 32 * nb, kb, scr, F.lane); continue; } r -= I3;
        if (r < I4) { const int kb = r / 32, nb = r % 32; p0_transpose_item(a.in[11], 1024, 32 * nb, nullptr, (bf16*)(ws + WS_WO), 1024, 32 * nb, kb, scr, F.lane); continue; } r -= I4;
        if (r < I5) { const int kb = r / 88, nb = r % 88, n0 = 32 * nb; p0_transpose_item(a.in[13], FF, n0, a.in[12], (bf16*)(ws + WS_WGU), 1024, 256 * (n0 >> 7) + (n0 & 127), kb, scr, F.lane); continue; } r -= I5;
        if (r < I6) { const int kb = r / 88, nb = r % 88, n0 = 32 * nb; p0_transpose_item(a.in[14], FF, n0, a.in[12], (bf16*)(ws + WS_WGU), 1024, 256 * (n0 >> 7) + 128 + (n0 & 127), kb, scr, F.lane); continue; } r -= I6;
        { const int kb = r / 32, nb = r % 32; p0_transpose_item(a.in[15], 1024, 32 * nb, nullptr, (bf16*)(ws + WS_WD), FF, 32 * nb, kb, scr, F.lane); }
    }
    const float* x = a.in[0]; const float* g1 = a.in[1]; const float* w_in = a.in[2];
    f32x4 gwa[4][4], gwb[4][4], g1v[4];
#pragma unroll
    for (int j = 0; j < 4; ++j) { g1v[j] = *(const f32x4*)(g1 + 256 * j + 4 * F.lane);
#pragma unroll
        for (int q = 0; q < 4; ++q) { const float* p = w_in + (size_t)(256 * j + 4 * F.lane + q) * INW + C_MI; gwa[j][q] = *(const f32x4*)p; gwb[j][q] = *(const f32x4*)(p + 4); } }
    bf16* XN = (bf16*)(ws + WS_XN); float* GATES = (float*)(ws + WS_GATES);
    for (int m = gw; m < M; m += NGW) {
        const GAS f32x4* xr = (const GAS f32x4*)(x + (size_t)m * D) + F.lane;
        f32x4 v[4]; float s = 0.f;
#pragma unroll
        for (int j = 0; j < 4; ++j) { v[j] = xr[64 * j]; s += (v[j].x * v[j].x + v[j].y * v[j].y) + (v[j].z * v[j].z + v[j].w * v[j].w); }
        const float r = rsqrtf(wave_sum(s) * (1.f / D) + EPS);
        GAS unsigned long long* o8 = (GAS unsigned long long*)(XN + (size_t)m * D) + F.lane;
        f32x4 ga = {0.f, 0.f, 0.f, 0.f}, gb = {0.f, 0.f, 0.f, 0.f};
#pragma unroll
        for (int j = 0; j < 4; ++j) { const f32x4 u = v[j] * r * g1v[j];
            o8[64 * j] = (unsigned long long)pk2(u.x, u.y) | ((unsigned long long)pk2(u.z, u.w) << 32);
            ga += gwa[j][0] * u.x + gwa[j][1] * u.y + gwa[j][2] * u.z + gwa[j][3] * u.w;
            gb += gwb[j][0] * u.x + gwb[j][1] * u.y + gwb[j][2] * u.z + gwb[j][3] * u.w; }
#pragma unroll
        for (int o = 1; o < 64; o <<= 1) {
#pragma unroll
            for (int e = 0; e < 4; ++e) { ga[e] += __shfl_xor(ga[e], o); gb[e] += __shfl_xor(gb[e], o); } }
        if (F.lane == 0) { *(GAS f32x4*)(GATES + (size_t)m * 8) = ga; *(GAS f32x4*)(GATES + (size_t)m * 8 + 4) = gb; }
    }
}

typedef pg8::f32x4 af4;
__device__ __forceinline__ v4u pack8(af4 v0, af4 v1) { v4u w; w.x = cvtpk(v0[0], v0[1]); w.y = cvtpk(v0[2], v0[3]); w.z = cvtpk(v1[0], v1[1]); w.w = cvtpk(v1[2], v1[3]); return w; }
__device__ __forceinline__ void unpack8(v4u w, af4& v0, af4& v1) {
    v0[0] = __builtin_bit_cast(float, w.x << 16); v0[1] = __builtin_bit_cast(float, w.x & 0xffff0000u); v0[2] = __builtin_bit_cast(float, w.y << 16); v0[3] = __builtin_bit_cast(float, w.y & 0xffff0000u);
    v1[0] = __builtin_bit_cast(float, w.z << 16); v1[1] = __builtin_bit_cast(float, w.z & 0xffff0000u); v1[2] = __builtin_bit_cast(float, w.w << 16); v1[3] = __builtin_bit_cast(float, w.w & 0xffff0000u); }
__device__ __forceinline__ af4 sig4(af4 v) { af4 o; o[0] = fast_sigmoid(v[0]); o[1] = fast_sigmoid(v[1]); o[2] = fast_sigmoid(v[2]); o[3] = fast_sigmoid(v[3]); return o; }

struct EpiG1 {
    static constexpr bool PERM = true, AFTER_DRAIN = false; unsigned char* ws;
    __device__ __forceinline__ void operator()(const af4 (&acc)[2][2][4][2], const pg8::Unit& u, int wr, int wc, int fr, int fq) const {
        const int pn = u.pn; size_t off; int ld, ct, act;
        if (pn < 2) { off = WS_QA; ld = 512; ct = pn; act = 1; } else if (pn == 2) { off = WS_KVA; ld = 256; ct = 0; act = 0; } else if (pn < 5) { off = WS_MQK; ld = 512; ct = pn - 3; act = 0; }
        else if (pn < 7) { off = WS_MV; ld = 512; ct = pn - 5; act = 0; } else if (pn < 9) { off = WS_MO; ld = 512; ct = pn - 7; act = 2; } else if (pn < 13) { off = WS_GA; ld = 1024; ct = pn - 9; act = 2; } else { off = WS_GM; ld = 1024; ct = pn - 13; act = 2; }
        bf16* base = (bf16*)(ws + off) + (size_t)(u.pm * 256 + wr * 64 + fr) * ld + ct * 256 + wc * 32 + 8 * fq;
#pragma unroll
        for (int ai = 0; ai < 2; ++ai)
#pragma unroll
            for (int m = 0; m < 4; ++m) { bf16* rowp = base + (size_t)(ai * 128 + m * 16) * ld;
#pragma unroll
                for (int bj = 0; bj < 2; ++bj) { af4 v0 = acc[ai][bj][m][0], v1 = acc[ai][bj][m][1];
                    if (act == 1) { v0 = v0 * QSCALE; v1 = v1 * QSCALE; } else if (act == 2) { v0 = sig4(v0); v1 = sig4(v1); }
                    *(v4u*)(rowp + bj * 128) = pack8(v0, v1); } }
    }
};
struct DualOrder {
    pg8::StaticOrder so;
    __device__ __forceinline__ bool next(int i, pg8::Unit& u) const { if (!so.next(i >> 1, u)) return false; u.sel = i & 1; return true; }
    __device__ __forceinline__ void a_ready(const pg8::Unit&) const {}
    __device__ __forceinline__ void done(const pg8::Unit&) const {}
};
struct EpiG2 {
    static constexpr bool PERM = true, AFTER_DRAIN = false; const bf16* GA; const bf16* GM; bf16* TMP; bf16* MG;
    __device__ __forceinline__ void operator()(const af4 (&acc)[2][2][4][2], const pg8::Unit& u, int wr, int wc, int fr, int fq) const {
        const size_t o0 = (size_t)(u.pm * 256 + wr * 64 + fr) * 1024 + u.pn * 256 + wc * 32 + 8 * fq;
#pragma unroll
        for (int ai = 0; ai < 2; ++ai)
#pragma unroll
            for (int m = 0; m < 4; ++m)
#pragma unroll
                for (int bj = 0; bj < 2; ++bj) { const size_t o = o0 + (size_t)(ai * 128 + m * 16) * 1024 + bj * 128; af4 g0, g1;
                    if (u.sel == 0) { unpack8(*(const v4u*)(GA + o), g0, g1); *(v4u*)(TMP + o) = pack8(acc[ai][bj][m][0] * g0, acc[ai][bj][m][1] * g1); }
                    else { af4 t0, t1; unpack8(*(const v4u*)(GM + o), g0, g1); unpack8(*(const v4u*)(TMP + o), t0, t1); *(v4u*)(MG + o) = pack8(acc[ai][bj][m][0] * g0 + t0, acc[ai][bj][m][1] * g1 + t1); } }
    }
};
struct EpiG3 {
    static constexpr bool PERM = true, AFTER_DRAIN = false; const float* x; float* out; bf16* X1B; float* SS;
    __device__ __forceinline__ void operator()(const af4 (&acc)[2][2][4][2], const pg8::Unit& u, int wr, int wc, int fr, int fq) const {
        const int row0 = u.pm * 256 + wr * 64 + fr; const size_t o0 = (size_t)row0 * 1024 + u.pn * 256 + wc * 32 + 8 * fq;
#pragma unroll
        for (int ai = 0; ai < 2; ++ai)
#pragma unroll
            for (int m = 0; m < 4; ++m) { float ss = 0.f;
#pragma unroll
                for (int bj = 0; bj < 2; ++bj) { const size_t o = o0 + (size_t)(ai * 128 + m * 16) * 1024 + bj * 128;
                    const af4 a0 = *(const af4*)(x + o) + acc[ai][bj][m][0], a1 = *(const af4*)(x + o + 4) + acc[ai][bj][m][1];
                    *(af4*)(out + o) = a0; *(af4*)(out + o + 4) = a1; *(v4u*)(X1B + o) = pack8(a0, a1);
                    ss += (a0[0] * a0[0] + a0[1] * a0[1]) + (a0[2] * a0[2] + a0[3] * a0[3]) + (a1[0] * a1[0] + a1[1] * a1[1]) + (a1[2] * a1[2] + a1[3] * a1[3]); }
                ss += __shfl_xor(ss, 16); ss += __shfl_xor(ss, 32);
                if (fq == 0) SS[(size_t)(row0 + ai * 128 + m * 16) * 16 + u.pn * 4 + wc] = ss; }
    }
};
struct EpiG4 {
    static constexpr bool PERM = true, AFTER_DRAIN = false; const float* SS; bf16* HB;
    __device__ __forceinline__ void operator()(const af4 (&acc)[2][2][4][2], const pg8::Unit& u, int wr, int wc, int fr, int fq) const {
        const int row0 = u.pm * 256 + wr * 64 + fr;
#pragma unroll
        for (int ai = 0; ai < 2; ++ai)
#pragma unroll
            for (int m = 0; m < 4; ++m) { const int row = row0 + ai * 128 + m * 16;
                const af4 p = *(const af4*)(SS + (size_t)row * 16 + 4 * fq); float s = (p[0] + p[1]) + (p[2] + p[3]); s += __shfl_xor(s, 16); s += __shfl_xor(s, 32);
                const float r = rsqrtf(s * (1.f / D) + EPS); af4 h0, h1;
#pragma unroll
                for (int e = 0; e < 4; ++e) { const float g0 = acc[ai][0][m][0][e] * r, g1 = acc[ai][0][m][1][e] * r; h0[e] = g0 * fast_sigmoid(g0) * (acc[ai][1][m][0][e] * r); h1[e] = g1 * fast_sigmoid(g1) * (acc[ai][1][m][1][e] * r); }
                *(v4u*)(HB + (size_t)row * FF + u.pn * 128 + wc * 32 + 8 * fq) = pack8(h0, h1); }
    }
};
struct EpiG5 {
    static constexpr bool PERM = true, AFTER_DRAIN = false; float* out;
    __device__ __forceinline__ void operator()(const af4 (&acc)[2][2][4][2], const pg8::Unit& u, int wr, int wc, int fr, int fq) const {
        const size_t o0 = (size_t)(u.pm * 256 + wr * 64 + fr) * 1024 + u.pn * 256 + wc * 32 + 8 * fq;
#pragma unroll
        for (int ai = 0; ai < 2; ++ai)
#pragma unroll
            for (int m = 0; m < 4; ++m)
#pragma unroll
                for (int bj = 0; bj < 2; ++bj) { const size_t o = o0 + (size_t)(ai * 128 + m * 16) * 1024 + bj * 128;
                    const af4 a0 = *(const af4*)(out + o) + acc[ai][bj][m][0], a1 = *(const af4*)(out + o + 4) + acc[ai][bj][m][1]; *(af4*)(out + o) = a0; *(af4*)(out + o + 4) = a1; }
    }
};
__device__ __forceinline__ void p_final_norm(Frame& F, float* out, const float* gF) {
    const int gw = F.vcu * NWAVES + F.wave, NGW = F.G * NWAVES;
    const int lane = (int)__builtin_amdgcn_mbcnt_hi(~0u, __builtin_amdgcn_mbcnt_lo(~0u, 0u));
    f32x4 gv[4];
#pragma unroll
    for (int j = 0; j < 4; ++j) gv[j] = *(const f32x4*)(gF + 256 * j + 4 * lane);
    for (int m = gw; m < M; m += NGW) { GAS f32x4* xr = (GAS f32x4*)(out + (size_t)m * D) + lane; f32x4 v[4]; float s = 0.f;
#pragma unroll
        for (int j = 0; j < 4; ++j) { v[j] = xr[64 * j]; s += (v[j].x * v[j].x + v[j].y * v[j].y) + (v[j].z * v[j].z + v[j].w * v[j].w); }
        const float r = rsqrtf(wave_sum(s) * (1.f / D) + EPS);
#pragma unroll
        for (int j = 0; j < 4; ++j) xr[64 * j] = v[j] * r * gv[j]; }
}

__global__ void __launch_bounds__(NTHREADS, 2) mega(Args args) {
    extern __shared__ __attribute__((aligned(16))) unsigned char lds[];
    Frame F;
    F.lds = (LAS unsigned char*)lds; F.MISC = (volatile LAS unsigned*)(F.lds + MISC_OFF);
    F.tid = threadIdx.x; F.lane = F.tid & 63; F.wave = __builtin_amdgcn_readfirstlane(F.tid >> 6);
    F.G = gridDim.x; { const int bx = blockIdx.x; F.vcu = (F.G % 8 == 0) ? (bx % 8) * (F.G / 8) + bx / 8 : bx; }
    unsigned char* ws = args.ws; F.ctl = (gu32*)(ws + WS_CTL);
    for (int u = F.tid; u < (LDS_BYTES - LDSCTL_OFF) / 4; u += NTHREADS) ((LAS unsigned*)(F.lds + LDSCTL_OFF))[u] = 0u;
    __syncthreads();
    const int lo = args.ph_lo, hi = args.ph_hi;
    XcdBarrier bar; bar.bar = (unsigned*)(F.ctl + CW_BAR) + args.li * XCD_BAR_WORDS; bar.x = 0; bar.st = nullptr;
    if (hi - lo > 1) bar = xcd_barrier_post((unsigned*)(F.ctl + CW_BAR) + args.li * XCD_BAR_WORDS, F.MISC + 8);
#define IN(k) (lo <= (k) && (k) < hi)
#define SEAM(k) do { if (IN(k) && IN((k) + 1)) xcd_barrier(bar); } while (0)
    float* out = args.out;
    if (IN(P_PRO)) { p0_prologue(F, args); SEAM(P_PRO); }
    if (IN(P_G1)) {
        pg8::Gemm g{(const bf16*)(ws + WS_XN), (const bf16*)(ws + WS_WIN), M, 4352, 1024, nullptr, nullptr}; pg8::StaticOrder S; S.init(M, 4352, F.G, (int)blockIdx.x);
        EpiG1 E{ws}; pg8::gemm_phase<EpiG1, pg8::StaticOrder, true, true>(F.lds + RING_OFF, g, S, E);
        SEAM(P_G1);
    }
    if (IN(P_MIX_A)) {
        attn::attn_phase((char*)lds + RING_OFF, F.vcu, F.G, (const bf16*)(ws + WS_QA), (const bf16*)(ws + WS_KVA), (bf16*)(ws + WS_AO), args.in[8]);
        mlstm::phase_a((char*)lds + RING_OFF, F.vcu, F.G, (const bf16*)(ws + WS_MQK), (const bf16*)(ws + WS_MV), (const float*)(ws + WS_GATES), args.in[3], args.in[4], args.in[5], args.in[6], (float*)(ws + WS_CLOC), (float*)(ws + WS_MSM));
        SEAM(P_MIX_A);
    }
    if (IN(P_SCAN)) { mlstm::phase_b(F.vcu, F.G, (const float*)(ws + WS_CLOC), (bf16*)(ws + WS_CST), (float*)(ws + WS_MSM)); SEAM(P_SCAN); }
    if (IN(P_MIX_C)) {
        mlstm::phase_c((char*)lds + RING_OFF, F.vcu, F.G, (const bf16*)(ws + WS_MQK), (const bf16*)(ws + WS_MV), (const bf16*)(ws + WS_MO), (const float*)(ws + WS_GATES), args.in[3], args.in[4], args.in[5], args.in[6], args.in[7],
                       (const bf16*)(ws + WS_CST), (const float*)(ws + WS_MSM), (bf16*)(ws + WS_HN));
        SEAM(P_MIX_C);
    }
    if (IN(P_G2)) {
        pg8::Gemm g{(const bf16*)(ws + WS_AO), (const bf16*)(ws + WS_WA), M, 1024, 512, (const bf16*)(ws + WS_HN), (const bf16*)(ws + WS_WM)}; DualOrder S; S.so.init(M, 1024, F.G, (int)blockIdx.x);
        EpiG2 E{(const bf16*)(ws + WS_GA), (const bf16*)(ws + WS_GM), (bf16*)(ws + WS_TMP), (bf16*)(ws + WS_MG)}; pg8::gemm_phase<EpiG2, DualOrder, true, true>(F.lds + RING_OFF, g, S, E);
        SEAM(P_G2);
    }
    if (IN(P_G3)) {
        pg8::Gemm g{(const bf16*)(ws + WS_MG), (const bf16*)(ws + WS_WO), M, 1024, 1024, nullptr, nullptr}; pg8::StaticOrder S; S.init(M, 1024, F.G, (int)blockIdx.x);
        EpiG3 E{args.in[0], out, (bf16*)(ws + WS_X1B), (float*)(ws + WS_SS1X)}; pg8::gemm_phase<EpiG3, pg8::StaticOrder, true, true>(F.lds + RING_OFF, g, S, E);
        SEAM(P_G3);
    }
    if (IN(P_G4)) {
        pg8::Gemm g{(const bf16*)(ws + WS_X1B), (const bf16*)(ws + WS_WGU), M, 2 * FF, 1024, nullptr, nullptr}; pg8::StaticOrder S; S.init(M, 2 * FF, F.G, (int)blockIdx.x);
        EpiG4 E{(const float*)(ws + WS_SS1X), (bf16*)(ws + WS_HB)}; pg8::gemm_phase<EpiG4, pg8::StaticOrder, true, true>(F.lds + RING_OFF, g, S, E);
        SEAM(P_G4);
    }
    if (IN(P_G5)) {
        pg8::Gemm g{(const bf16*)(ws + WS_HB), (const bf16*)(ws + WS_WD), M, 1024, FF, nullptr, nullptr}; pg8::StaticOrder S; S.init(M, 1024, F.G, (int)blockIdx.x);
        EpiG5 E{out}; pg8::gemm_phase<EpiG5, pg8::StaticOrder, true, true>(F.lds + RING_OFF, g, S, E);
        SEAM(P_G5);
    }
    if (IN(P_FIN)) { p_final_norm(F, out, args.in[16]); }
#undef IN
#undef SEAM
}
}
extern "C" void kernel_launch(void* const* d_in, const int* in_sizes, int n_in, void* d_out, int out_size, void* d_ws, size_t ws_size, hipStream_t stream) {
    using namespace cfg;
    static int grid = 0;
    if (grid == 0) {
        if (n_in != 17 || in_sizes[0] != M * D || out_size != M * D || ws_size < WS_END) { fprintf(stderr, "kernel_launch: unexpected shapes n_in %d in0 %d out %d ws %zu\n", n_in, in_sizes[0], out_size, ws_size); grid = -1; return; }
        int dev = 0, cus = 0;
        if (hipGetDevice(&dev) != hipSuccess || hipDeviceGetAttribute(&cus, hipDeviceAttributeMultiprocessorCount, dev) != hipSuccess) { grid = -1; return; }
        if (hipFuncSetAttribute((const void*)mk::mega, hipFuncAttributeMaxDynamicSharedMemorySize, mk::LDS_BYTES) != hipSuccess) { fprintf(stderr, "kernel_launch: hipFuncSetAttribute failed\n"); grid = -1; return; }
        grid = cus;
    }
    if (grid < 0) return;
    unsigned char* ws = (unsigned char*)d_ws;
    (void)hipMemsetAsync(ws + WS_CTL, 0, MiB, stream);
    mk::Args a{}; for (int i = 0; i < 17; ++i) a.in[i] = (const float*)d_in[i]; a.out = (float*)d_out; a.ws = ws; a.ph_lo = 0; a.ph_hi = mk::N_PHASES; a.li = 0;
    hipLaunchKernelGGL(mk::mega, dim3(grid), dim3(mk::NTHREADS), mk::LDS_BYTES, stream, a);
}
```
